# Optimizing an MI355X kernel written in HIP

```python
import math, functools
import jax, jax.numpy as jnp
from jax import lax
import numpy as np

D_MODEL = 1024
BATCH = 4
SEQ = 8192
DEPTH = 4

N_MIXERS = 3
MEM_LEN = 256
BLOCK = 128
ROPE_THETA = 10000.0
NEG = -1e30
LN_EPS = 1e-5
RMS_EPS = 1e-6

A_HEADS = 16
A_KV_HEADS = 4
A_HEAD_DIM = 64
A_WINDOW = 128

LRU_WIDTH = D_MODEL
LRU_BLOCKS = 4
LRU_BLOCK_W = LRU_WIDTH // LRU_BLOCKS
LRU_CONV = 4
LRU_C = 8.0

C_HEADS = 8
C_NOPE = 128
C_ROPE = 64
C_V = 128
C_Q_RANK = 384
C_KV_RANK = 256

X_HEADS = 4
X_HEAD_DIM = D_MODEL // X_HEADS

D_FF = 2816
FFN_CONV = 3

ALPHA = (2.0 * DEPTH) ** 0.25
BETA = (8.0 * DEPTH) ** -0.25

N_A = (DEPTH + 2) // 3
N_B = (DEPTH + 1) // 3
N_C = DEPTH // 3

kernel_name = "interleaved_swa_rglru_mla_deepnorm_trunk"


def layer_norm(x, g, b):
    xf = x.astype(jnp.float32)
    mu = jnp.mean(xf, axis=-1, keepdims=True)
    var = jnp.mean(jnp.square(xf - mu), axis=-1, keepdims=True)
    y = (xf - mu) * lax.rsqrt(var + LN_EPS) * g.astype(jnp.float32) + b.astype(jnp.float32)
    return y.astype(x.dtype)


def rms_norm(x, g):
    xf = x.astype(jnp.float32)
    y = xf * lax.rsqrt(jnp.mean(jnp.square(xf), axis=-1, keepdims=True) + RMS_EPS)
    return (y * g.astype(jnp.float32)).astype(x.dtype)


def rope_tables(seq, dim):
    inv = 1.0 / (ROPE_THETA ** (jnp.arange(0, dim, 2, dtype=jnp.float32) / dim))
    ang = jnp.arange(seq, dtype=jnp.float32)[:, None] * inv[None, :]
    return jnp.cos(ang), jnp.sin(ang)


def apply_rope(x, cos, sin):
    c = cos[None, :, None, :].astype(x.dtype)
    s = sin[None, :, None, :].astype(x.dtype)
    x1, x2 = jnp.split(x, 2, axis=-1)
    return jnp.concatenate([x1 * c - x2 * s, x2 * c + x1 * s], axis=-1)


def causal_depthwise_conv(x, w, b):
    k_width = w.shape[0]
    s = x.shape[1]
    xp = jnp.pad(x, ((0, 0), (k_width - 1, 0), (0, 0)))
    y = xp[:, 0:s] * w[0]
    for k in range(1, k_width):
        y = y + xp[:, k:k + s] * w[k]
    return y + b


def swa_sink_attention(x, w_qkv, sinks, w_o, cos, sin):
    bsz, s, _ = x.shape
    grp = A_HEADS // A_KV_HEADS
    nb = s // BLOCK
    qkv = x @ w_qkv
    q, k, v = jnp.split(qkv, [A_HEADS * A_HEAD_DIM, (A_HEADS + A_KV_HEADS) * A_HEAD_DIM], axis=-1)
    q = apply_rope(q.reshape(bsz, s, A_HEADS, A_HEAD_DIM), cos, sin)
    k = apply_rope(k.reshape(bsz, s, A_KV_HEADS, A_HEAD_DIM), cos, sin)
    v = v.reshape(bsz, s, A_KV_HEADS, A_HEAD_DIM)
    qb = q.reshape(bsz, nb, BLOCK, A_KV_HEADS, grp, A_HEAD_DIM)

    def with_prev(t):
        tb = t.reshape(bsz, nb, BLOCK, A_KV_HEADS, A_HEAD_DIM)
        prev = jnp.pad(tb[:, :-1], ((0, 0), (1, 0), (0, 0), (0, 0), (0, 0)))
        return jnp.concatenate([prev, tb], axis=2)

    kb, vb = with_prev(k), with_prev(v)
    scores = jnp.einsum('bnqhgd,bnkhd->bnhgqk', qb, kb).astype(jnp.float32) * (A_HEAD_DIM ** -0.5)
    qi = jnp.arange(BLOCK)[:, None]
    kj = jnp.arange(2 * BLOCK)[None, :]
    dist = qi + BLOCK - kj
    band = (dist >= 0) & (dist < A_WINDOW)
    real_key = (jnp.arange(nb)[:, None, None] > 0) | (kj >= BLOCK)[None]
    valid = band[None] & real_key
    scores = jnp.where(valid[None, :, None, None], scores, NEG)
    sink = sinks.astype(jnp.float32).reshape(A_KV_HEADS, grp)[None, None, :, :, None, None]
    sink = jnp.broadcast_to(sink, scores.shape[:-1] + (1,))
    probs = jax.nn.softmax(jnp.concatenate([scores, sink], axis=-1), axis=-1)[..., :-1]
    out = jnp.einsum('bnhgqk,bnkhd->bnqhgd', probs.astype(v.dtype), vb)
    return out.reshape(bsz, s, A_HEADS * A_HEAD_DIM) @ w_o


def rglru_block(x, w_in, conv_w, conv_b, w_rgate, b_rgate, w_igate, b_igate, lam, w_o):
    bsz, s, _ = x.shape
    gate, u = jnp.split(x @ w_in, 2, axis=-1)
    u = causal_depthwise_conv(u, conv_w, conv_b)
    ub = u.reshape(bsz, s, LRU_BLOCKS, LRU_BLOCK_W)
    r = jax.nn.sigmoid(jnp.einsum('bshi,hij->bshj', ub, w_rgate).reshape(bsz, s, LRU_WIDTH) + b_rgate)
    i = jax.nn.sigmoid(jnp.einsum('bshi,hij->bshj', ub, w_igate).reshape(bsz, s, LRU_WIDTH) + b_igate)
    log_a = -LRU_C * r.astype(jnp.float32) * jax.nn.softplus(-lam.astype(jnp.float32))
    a = jnp.exp(log_a)
    b_in = jnp.sqrt(-jnp.expm1(2.0 * log_a)) * (i * u).astype(jnp.float32)

    def combine(c1, c2):
        a1, b1 = c1
        a2, b2 = c2
        return a1 * a2, a2 * b1 + b2

    _, h = lax.associative_scan(combine, (a, b_in), axis=1)
    y = h.astype(x.dtype) * jax.nn.gelu(gate)
    return y @ w_o


def mla_attention(x, w_down, q_norm, kv_norm, w_uq, w_ukv, w_o, cos_r, sin_r):
    bsz, s, _ = x.shape
    nb = s // BLOCK
    c = x @ w_down
    cq, ckv, k_rope = jnp.split(c, [C_Q_RANK, C_Q_RANK + C_KV_RANK], axis=-1)
    cq = rms_norm(cq, q_norm)
    ckv = rms_norm(ckv, kv_norm)
    q = (cq @ w_uq).reshape(bsz, s, C_HEADS, C_NOPE + C_ROPE)
    q_nope, q_rope = jnp.split(q, [C_NOPE], axis=-1)
    q_rope = apply_rope(q_rope, cos_r, sin_r)
    k_rope = apply_rope(k_rope[:, :, None, :], cos_r, sin_r)[:, :, 0]
    kv = (ckv @ w_ukv).reshape(bsz, s, C_HEADS, C_NOPE + C_V)
    k_nope, v = jnp.split(kv, [C_NOPE], axis=-1)
    scale = (C_NOPE + C_ROPE) ** -0.5
    qn = q_nope.reshape(bsz, nb, BLOCK, C_HEADS, C_NOPE).transpose(1, 0, 2, 3, 4)
    qr = q_rope.reshape(bsz, nb, BLOCK, C_HEADS, C_ROPE).transpose(1, 0, 2, 3, 4)
    key_pos = jnp.arange(s)

    def attend(args):
        n, qn_b, qr_b = args
        sc = (jnp.einsum('bqhd,bkhd->bhqk', qn_b, k_nope)
              + jnp.einsum('bqhd,bkd->bhqk', qr_b, k_rope)).astype(jnp.float32) * scale
        q_pos = n * BLOCK + jnp.arange(BLOCK)
        sc = jnp.where(key_pos[None, :] <= q_pos[:, None], sc, NEG)
        p = jax.nn.softmax(sc, axis=-1)
        return jnp.einsum('bhqk,bkhd->bqhd', p.astype(v.dtype), v)

    out = lax.map(attend, (jnp.arange(nb), qn, qr))
    out = out.transpose(1, 0, 2, 3, 4).reshape(bsz, s, C_HEADS * C_V)
    return out @ w_o


def memory_cross_attention(x, mem_k, mem_v, w_q, w_o):
    bsz, s, _ = x.shape
    q = (x @ w_q).reshape(bsz, s, X_HEADS, X_HEAD_DIM)
    sc = jnp.einsum('bshd,bmhd->bhsm', q, mem_k).astype(jnp.float32) * (X_HEAD_DIM ** -0.5)
    p = jax.nn.softmax(sc, axis=-1)
    o = jnp.einsum('bhsm,bmhd->bshd', p.astype(mem_v.dtype), mem_v).reshape(bsz, s, D_MODEL)
    return o @ w_o


def conv_glu_ffn(x, w_up, conv_w, conv_b, w_down):
    h = causal_depthwise_conv(x @ w_up, conv_w, conv_b)
    g, u = jnp.split(h, 2, axis=-1)
    return (jax.nn.silu(g) * u) @ w_down


def setup_inputs(seed: int = 0) -> dict:
    key = jax.random.key(seed)
    ks = iter(jax.random.split(key, 40))

    def dense(shape, fan_in, scale=1.0):
        return jax.random.normal(next(ks), shape, jnp.float32) * (scale * fan_in ** -0.5)

    def small(shape, scale=0.01):
        return jax.random.normal(next(ks), shape, jnp.float32) * scale

    def gain(shape):
        return 1.0 + small(shape)

    qkv_w = (A_HEADS + 2 * A_KV_HEADS) * A_HEAD_DIM
    a0 = jax.random.uniform(next(ks), (N_B, LRU_WIDTH), jnp.float32, 0.9, 0.999) ** (1.0 / LRU_C)
    return {
        "x": jax.random.normal(next(ks), (BATCH, SEQ, D_MODEL), jnp.float32),
        "mem": jax.random.normal(next(ks), (BATCH, MEM_LEN, D_MODEL), jnp.float32),
        "a_w_qkv": dense((N_A, D_MODEL, qkv_w), D_MODEL),
        "a_sinks": small((N_A, A_HEADS), 1.0),
        "a_w_o": dense((N_A, A_HEADS * A_HEAD_DIM, D_MODEL), A_HEADS * A_HEAD_DIM, BETA),
        "b_w_in": dense((N_B, D_MODEL, 2 * LRU_WIDTH), D_MODEL),
        "b_conv_w": dense((N_B, LRU_CONV, LRU_WIDTH), LRU_CONV),
        "b_conv_b": small((N_B, LRU_WIDTH)),
        "b_w_rgate": dense((N_B, LRU_BLOCKS, LRU_BLOCK_W, LRU_BLOCK_W), LRU_BLOCK_W),
        "b_b_rgate": small((N_B, LRU_WIDTH)),
        "b_w_igate": dense((N_B, LRU_BLOCKS, LRU_BLOCK_W, LRU_BLOCK_W), LRU_BLOCK_W),
        "b_b_igate": small((N_B, LRU_WIDTH)),
        "b_lambda": jnp.log(a0) - jnp.log1p(-a0),
        "b_w_o": dense((N_B, LRU_WIDTH, D_MODEL), LRU_WIDTH, BETA),
        "c_w_down": dense((N_C, D_MODEL, C_Q_RANK + C_KV_RANK + C_ROPE), D_MODEL),
        "c_q_norm": gain((N_C, C_Q_RANK)),
        "c_kv_norm": gain((N_C, C_KV_RANK)),
        "c_w_uq": dense((N_C, C_Q_RANK, C_HEADS * (C_NOPE + C_ROPE)), C_Q_RANK),
        "c_w_ukv": dense((N_C, C_KV_RANK, C_HEADS * (C_NOPE + C_V)), C_KV_RANK),
        "c_w_o": dense((N_C, C_HEADS * C_V, D_MODEL), C_HEADS * C_V, BETA),
        "mem_w_kv": dense((D_MODEL, 2 * D_MODEL), D_MODEL),
        "x_w_q": dense((DEPTH, D_MODEL, D_MODEL), D_MODEL),
        "x_w_o": dense((DEPTH, D_MODEL, D_MODEL), D_MODEL, BETA),
        "f_w_up": dense((DEPTH, D_MODEL, 2 * D_FF), D_MODEL),
        "f_conv_w": dense((DEPTH, FFN_CONV, 2 * D_FF), FFN_CONV),
        "f_conv_b": small((DEPTH, 2 * D_FF)),
        "f_w_down": dense((DEPTH, D_FF, D_MODEL), D_FF, BETA),
        "ln_g": gain((DEPTH, 3, D_MODEL)),
        "ln_b": small((DEPTH, 3, D_MODEL)),
    }


def reference(x, mem, a_w_qkv, a_sinks, a_w_o, b_w_in, b_conv_w, b_conv_b, b_w_rgate, b_b_rgate,
              b_w_igate, b_b_igate, b_lambda, b_w_o, c_w_down, c_q_norm, c_kv_norm, c_w_uq, c_w_ukv,
              c_w_o, mem_w_kv, x_w_q, x_w_o, f_w_up, f_conv_w, f_conv_b, f_w_down, ln_g, ln_b):
    bsz, s, _ = x.shape
    cos_a, sin_a = rope_tables(s, A_HEAD_DIM)
    cos_c, sin_c = rope_tables(s, C_ROPE)
    mem_k, mem_v = jnp.split(mem @ mem_w_kv, 2, axis=-1)
    mem_k = mem_k.reshape(bsz, MEM_LEN, X_HEADS, X_HEAD_DIM)
    mem_v = mem_v.reshape(bsz, MEM_LEN, X_HEADS, X_HEAD_DIM)
    for i in range(DEPTH):
        kind, j = i % N_MIXERS, i // N_MIXERS
        if kind == 0:
            y = swa_sink_attention(x, a_w_qkv[j], a_sinks[j], a_w_o[j], cos_a, sin_a)
        elif kind == 1:
            y = rglru_block(x, b_w_in[j], b_conv_w[j], b_conv_b[j], b_w_rgate[j], b_b_rgate[j],
                            b_w_igate[j], b_b_igate[j], b_lambda[j], b_w_o[j])
        else:
            y = mla_attention(x, c_w_down[j], c_q_norm[j], c_kv_norm[j], c_w_uq[j], c_w_ukv[j],
                              c_w_o[j], cos_c, sin_c)
        x = layer_norm(ALPHA * x + y, ln_g[i, 0], ln_b[i, 0])
        x = layer_norm(ALPHA * x + memory_cross_attention(x, mem_k, mem_v, x_w_q[i], x_w_o[i]),
                       ln_g[i, 1], ln_b[i, 1])
        x = layer_norm(ALPHA * x + conv_glu_ffn(x, f_w_up[i], f_conv_w[i], f_conv_b[i], f_w_down[i]),
                       ln_g[i, 2], ln_b[i, 2])
    return x
```

```cpp
#include <hip/hip_runtime.h>
#include <hip/hip_cooperative_groups.h>
#include <cstdio>
#include <cstdint>
namespace cg = cooperative_groups;

#ifndef MULTI_LAUNCH
#define MULTI_LAUNCH 0
#endif

#define LAS __attribute__((address_space(3)))
#define DI __device__ __forceinline__
typedef unsigned short bf16_t;
typedef short bf16x8 __attribute__((ext_vector_type(8)));
typedef short s16x4 __attribute__((ext_vector_type(4)));
typedef float f32x2 __attribute__((ext_vector_type(2)));
typedef float f32x4 __attribute__((ext_vector_type(4)));
typedef float f32x16 __attribute__((ext_vector_type(16)));
typedef unsigned u32x2 __attribute__((ext_vector_type(2)));
typedef unsigned u32x4 __attribute__((ext_vector_type(4)));
typedef _Float16 h16x2 __attribute__((ext_vector_type(2)));
typedef _Float16 h16x8 __attribute__((ext_vector_type(8)));

constexpr int SEQ = 8192, MTOK = 32768;
constexpr float ALPHA_F = 1.6817928305074290f;
constexpr float LOG2E = 1.4426950408889634f;
constexpr size_t MiB = (size_t)1 << 20;
constexpr int LDS_BYTES = 131072 + 64 + 10240 + 64;
constexpr int NPHASES = 50;
constexpr size_t WS_WB = 0, WS_MISC = 32 * MiB, WS_XB = 48 * MiB, WS_T = 112 * MiB, WS_NEED = 512 * MiB;
constexpr size_t OFF_M1 = 0, OFF_M2 = (size_t)2 << 20, OFF_M3 = (size_t)3 << 20, OFF_MO = (size_t)4 << 20, OFF_XQ = (size_t)5 << 20,
                 OFF_XO = (size_t)6 << 20, OFF_FU = (size_t)7 << 20, OFF_FD = (size_t)13 << 20;
constexpr size_t MS_COS = 0, MS_SIN = 1 * MiB, MS_MEMB = 2 * MiB, MS_KMEM = 4 * MiB, MS_VT = 6 * MiB, MS_RSQ = 8 * MiB, MS_RSKV = 8 * MiB + 131072,
                 MS_XSUM = 9 * MiB, MS_SP = 11 * MiB, MS_SH = 12 * MiB, MS_BAR = 14 * MiB;

struct Params { const float* in[29]; float* out; unsigned char* ws; int ph_lo, ph_hi; };
struct Ctx { int tid, bid; };

DI unsigned pk2(float a, float b) { f32x2 v = {a, b}; h16x2 r = __builtin_convertvector(v, h16x2); return __builtin_bit_cast(unsigned, r); }
DI float bf_lo(unsigned w) { return (float)__builtin_bit_cast(h16x2, w)[0]; }
DI float bf_hi(unsigned w) { return (float)__builtin_bit_cast(h16x2, w)[1]; }
DI float fexp2(float x) { return __builtin_amdgcn_exp2f(x); }
DI float fexp(float x) { return __builtin_amdgcn_exp2f(x * LOG2E); }
struct V8 { f32x4 a, b; };
DI V8 unpack8(u32x4 w) { V8 r; r.a = (f32x4){bf_lo(w.x), bf_hi(w.x), bf_lo(w.y), bf_hi(w.y)}; r.b = (f32x4){bf_lo(w.z), bf_hi(w.z), bf_lo(w.w), bf_hi(w.w)}; return r; }
DI u32x4 pack8(const V8& v) { u32x4 w; w.x = pk2(v.a.x, v.a.y); w.y = pk2(v.a.z, v.a.w); w.z = pk2(v.b.x, v.b.y); w.w = pk2(v.b.z, v.b.w); return w; }
DI V8 ldf8(const float* p) { V8 r; r.a = *(const f32x4*)p; r.b = *(const f32x4*)(p + 4); return r; }
DI float wave_sum(float v) {
#pragma unroll
    for (int o = 1; o < 64; o <<= 1) v += __shfl_xor(v, o);
    return v;
}
#define LDS_WAIT() asm volatile("s_waitcnt lgkmcnt(0)" ::: "memory")

constexpr int BM = 256, BK = 64, HALF = 128, HTB = HALF * BK * 2;
enum { EPI_BF16 = 0, EPI_RES = 1, EPI_SIG = 2, EPI_EXP = 3, EPI_DIV = 4, EPI_GLU = 5, EPI_EXPN = 6 };
constexpr size_t MS_CNT = 14 * MiB + 16384;
enum { ROPE_NONE = 0, ROPE_SWA = 1, ROPE_MLAQ = 2 };
struct GemmD {
    const bf16_t* A; const bf16_t* Bt; int lda, ldb, M, N, K, G;
    long sA1, sA2, sB1, sB2, sC1, sC2;
    int epi, opt, ldc, growstep, gshift, rot;
    void* C; const float* aux0; const float* aux1; const float* cosT; const float* sinT; float scale;
};
struct Unit { int pm, pn, g; };

DI int lds_byte(int r, int c) { const int st = (r >> 4) * 2 + (c >> 5), rr = r & 15, cc = c & 31, ob = rr * 64 + cc * 2; return st * 1024 + (ob ^ (((ob >> 9) & 1) << 5)); }
DI void stage_rc(int b, int& R, int& C) { const int st = b / 1024, sb = b % 1024, swz = sb ^ (((sb >> 9) & 1) << 5); R = (st >> 1) * 16 + swz / 64; C = (st & 1) * 32 + (swz % 64) / 2; }
DI int perm32(int rho) { const int n = rho >> 4, i = rho & 15; return 8 * (i >> 2) + 4 * n + (i & 3); }

DI bool next_unit(const Ctx& cx, const GemmD& g, int i, Unit& u) {
    const int nM = g.M >> 8, nN = g.N >> 8, nwg1 = nM * nN, nwg = nwg1 * g.G;
    const int G_ = (int)gridDim.x; int vb = cx.bid - g.rot; if (vb < 0) vb += G_;
    const long L = (long)i * G_ + vb; if (L >= nwg) return false;
    int wgid = (int)L; { const int q = nwg / 8, r = nwg % 8, xcd = wgid % 8, off = wgid / 8; wgid = (xcd < r ? xcd * (q + 1) : r * (q + 1) + (xcd - r) * q) + off; }
    u.g = wgid / nwg1; wgid -= u.g * nwg1;
    const int nig = 8 * nN, gid = wgid / nig, fm = gid * 8, gsz = (nM - fm) < 8 ? (nM - fm) : 8;
    u.pm = fm + ((wgid % nig) % gsz); u.pn = (wgid % nig) / gsz; return true;
}

DI void gemm_epilogue(const GemmD& g, f32x4 (&acc)[2][2][4][2], const Unit& u, int wr, int wc, int fr_, int fq_, LAS unsigned char* lds) {
    int fr = fr_, fq = fq_; asm volatile("" : "+v"(fr), "+v"(fq));
    const int g1 = u.g >> g.gshift, g2 = u.g & ((1 << g.gshift) - 1);
    const int lrow0 = u.pm * BM + wr * 64 + fr;
    if (g.epi == EPI_RES) {
        float* C = (float*)g.C; const float* R = g.aux1 ? g.aux1 : (const float*)g.C;
        unsigned long long* xbuf = (unsigned long long*)g.aux0; unsigned* cnt = (unsigned*)((unsigned char*)g.aux0 + (MS_CNT - MS_SP)); bf16_t* XBo = (bf16_t*)((unsigned char*)g.aux0 + (WS_XB - WS_MISC - MS_SP));
        const unsigned want = (unsigned)g.opt;
        const int col0 = u.pn * BM + wc * 32 + 4 * fq;
        const int grow_t = g1 * g.growstep + u.pm * BM, panel = grow_t >> 8;
        const int wid = wr * 4 + wc, lane = fq * 16 + fr;
        LAS f32x2* P = (LAS f32x2*)(lds + 131072 + 64);
        LAS f32x2* S = (LAS f32x2*)(lds + 131072 + 64 + 8192);
#pragma unroll
        for (int ai = 0; ai < 2; ++ai)
#pragma unroll
            for (int m = 0; m < 4; ++m) {
                const int lr = ai * HALF + wr * 64 + m * 16 + fr; const float* rp = R + (size_t)(grow_t + lr) * g.ldc + col0;
                float sm = 0.f;
#pragma unroll
                for (int bj = 0; bj < 2; ++bj) {
#pragma unroll
                    for (int n = 0; n < 2; ++n) { const f32x4 x = *(const f32x4*)(rp + bj * HALF + n * 16); const f32x4 v = x * ALPHA_F + acc[ai][bj][m][n]; acc[ai][bj][m][n] = v; sm += (v[0] + v[1]) + (v[2] + v[3]); } }
                sm += __shfl_xor(sm, 16); sm += __shfl_xor(sm, 32);
                const float mw = sm * (1.0f / 64.0f); float q = 0.f;
#pragma unroll
                for (int bj = 0; bj < 2; ++bj)
#pragma unroll
                    for (int n = 0; n < 2; ++n) { const f32x4 dd = acc[ai][bj][m][n] - mw; q += (dd[0] * dd[0] + dd[1] * dd[1]) + (dd[2] * dd[2] + dd[3] * dd[3]); }
                q += __shfl_xor(q, 16); q += __shfl_xor(q, 32);
                if (fq == 0) P[lr * 4 + wc] = (f32x2){mw, q};
                if (m & 1) asm volatile("" ::: "memory");
            }
        asm volatile("s_waitcnt lgkmcnt(0)" ::: "memory"); __builtin_amdgcn_s_barrier(); asm volatile("" ::: "memory");
        const int prow = wid * 32 + (lane & 31);
        if (lane < 32) {
            const f32x2 a = P[prow * 4 + 0], b = P[prow * 4 + 1], c = P[prow * 4 + 2], d4 = P[prow * 4 + 3];
            const float mt = (a.x + b.x + c.x + d4.x) * 0.25f;
            const float da = a.x - mt, db = b.x - mt, dc = c.x - mt, dd = d4.x - mt;
            const float m2 = (a.y + b.y) + (c.y + d4.y) + 64.0f * ((da * da + db * db) + (dc * dc + dd * dd));
            __hip_atomic_store(xbuf + ((size_t)(grow_t + prow) * 4 + u.pn), ((unsigned long long)__float_as_uint(m2) << 32) | __float_as_uint(mt), __ATOMIC_RELAXED, __HIP_MEMORY_SCOPE_AGENT);
        }
        asm volatile("s_waitcnt vmcnt(0)" ::: "memory");
        if (lane == 0) __hip_atomic_fetch_add(cnt + 64 * panel, 1u, __ATOMIC_RELAXED, __HIP_MEMORY_SCOPE_AGENT);
        if (wid == 0) {
            unsigned spins = 0;
            while ((unsigned)__builtin_amdgcn_readfirstlane(__hip_atomic_load(cnt + 64 * panel, __ATOMIC_RELAXED, __HIP_MEMORY_SCOPE_AGENT)) < want) { __builtin_amdgcn_s_sleep(2); if (++spins > (1u << 22)) break; }
            __builtin_amdgcn_fence(__ATOMIC_ACQUIRE, "agent");
        }
        asm volatile("s_waitcnt vmcnt(0) lgkmcnt(0)" ::: "memory"); __builtin_amdgcn_s_barrier(); asm volatile("" ::: "memory");
        if (lane < 32) {
            const unsigned long long* slot = xbuf + (size_t)(grow_t + prow) * 4; float mt[4], m2[4]; float ms = 0.f;
#pragma unroll
            for (int t = 0; t < 4; ++t) { const unsigned long long w = __hip_atomic_load(slot + t, __ATOMIC_RELAXED, __HIP_MEMORY_SCOPE_AGENT); mt[t] = __uint_as_float((unsigned)w); m2[t] = __uint_as_float((unsigned)(w >> 32)); ms += mt[t]; }
            const float mean = ms * 0.25f; float q = 0.f;
#pragma unroll
            for (int t = 0; t < 4; ++t) { const float dm = mt[t] - mean; q += m2[t] + 256.0f * dm * dm; }
            S[prow] = (f32x2){mean, 1.0f / sqrtf(q * (1.0f / 1024.0f) + 1e-5f)};
        }
        asm volatile("s_waitcnt lgkmcnt(0)" ::: "memory"); __builtin_amdgcn_s_barrier(); asm volatile("" ::: "memory");
        const float* lg = g.cosT + col0; const float* lb = g.sinT + col0;
#pragma unroll
        for (int ai = 0; ai < 2; ++ai)
#pragma unroll
            for (int m = 0; m < 4; ++m) {
                const int lr = ai * HALF + wr * 64 + m * 16 + fr; const f32x2 sr = S[lr];
                float* cp = C + (size_t)(grow_t + lr) * g.ldc + col0; bf16_t* xp = XBo + (size_t)(grow_t + lr) * g.ldc + col0;
#pragma unroll
                for (int bj = 0; bj < 2; ++bj)
#pragma unroll
                    for (int n = 0; n < 2; ++n) {
                        const f32x4 gvv = *(const f32x4*)(lg + bj * HALF + n * 16), bvv = *(const f32x4*)(lb + bj * HALF + n * 16);
                        const f32x4 y = (acc[ai][bj][m][n] - sr.x) * sr.y * gvv + bvv;
                        *(f32x4*)(cp + bj * HALF + n * 16) = y;
                        u32x2 w; w.x = pk2(y[0], y[1]); w.y = pk2(y[2], y[3]); *(u32x2*)(xp + bj * HALF + n * 16) = w;
                    }
                asm volatile("" ::: "memory");
            }
        return;
    }
    if (g.epi == EPI_EXPN) {
        LAS float* X = (LAS float*)(lds + 131072 + 64);
        const float sc = g.scale * LOG2E;
#pragma unroll
        for (int ai = 0; ai < 2; ++ai)
#pragma unroll
            for (int m = 0; m < 4; ++m) {
                float rsum = 0.f;
#pragma unroll
                for (int bj = 0; bj < 2; ++bj)
#pragma unroll
                    for (int n = 0; n < 2; ++n) {
#pragma unroll
                        for (int j = 0; j < 4; ++j) { const float e = fexp2(fminf(acc[ai][bj][m][n][j] * sc - 5.77f, 15.9f)); rsum += e; } }
                rsum += __shfl_xor(rsum, 16); rsum += __shfl_xor(rsum, 32);
                if (fq == 0) X[(ai * HALF + wr * 64 + m * 16 + fr) * 4 + wc] = rsum;
                __builtin_amdgcn_sched_barrier(0);
            }
        asm volatile("s_waitcnt lgkmcnt(0)" ::: "memory"); __builtin_amdgcn_s_barrier(); asm volatile("" ::: "memory");
    }
    if (g.epi == EPI_GLU) {
        bf16_t* ACT = (bf16_t*)g.C; bf16_t* HF = (bf16_t*)g.cosT; bf16_t* HL = (bf16_t*)g.sinT;
        const float* cw = g.aux0; const float* cb = g.aux1;
        const int ch0 = u.pn * 128 + wc * 32 + 8 * fq;
        f32x4 wg[2][3], wu[2][3], bgv[2], buv[2];
#pragma unroll
        for (int n = 0; n < 2; ++n) {
#pragma unroll
            for (int k = 0; k < 3; ++k) { wg[n][k] = *(const f32x4*)(cw + k * 5632 + ch0 + 4 * n); wu[n][k] = *(const f32x4*)(cw + k * 5632 + 2816 + ch0 + 4 * n); }
            bgv[n] = *(const f32x4*)(cb + ch0 + 4 * n); buv[n] = *(const f32x4*)(cb + 2816 + ch0 + 4 * n);
        }
#pragma unroll
        for (int ai = 0; ai < 2; ++ai) {
            const int rbase = u.pm * BM + ai * HALF + wr * 64, blk = rbase >> 6;
#pragma unroll
            for (int m = 0; m < 4; ++m) {
                const int row = rbase + 16 * m + fr;
                f32x4 o[2];
#pragma unroll
                for (int n = 0; n < 2; ++n) {
                    const f32x4 G = acc[ai][0][m][n], U = acc[ai][1][m][n];
                    f32x4 Gp = {0.f, 0.f, 0.f, 0.f}, Up = Gp;
                    if (m > 0) { Gp = acc[ai][0][m > 0 ? m - 1 : 0][n]; Up = acc[ai][1][m > 0 ? m - 1 : 0][n]; }
                    f32x4 g1, g2, u1, u2;
#pragma unroll
                    for (int j = 0; j < 4; ++j) {
                        const int gi = __float_as_int(G[j]), gpi = __float_as_int(Gp[j]), ui = __float_as_int(U[j]), upi = __float_as_int(Up[j]);
                        g1[j] = __int_as_float(__builtin_amdgcn_update_dpp(__builtin_amdgcn_update_dpp(0, gpi, 0x121, 0xf, 0xf, false), gi, 0x111, 0xf, 0xf, false));
                        g2[j] = __int_as_float(__builtin_amdgcn_update_dpp(__builtin_amdgcn_update_dpp(0, gpi, 0x122, 0xf, 0xf, false), gi, 0x112, 0xf, 0xf, false));
                        u1[j] = __int_as_float(__builtin_amdgcn_update_dpp(__builtin_amdgcn_update_dpp(0, upi, 0x121, 0xf, 0xf, false), ui, 0x111, 0xf, 0xf, false));
                        u2[j] = __int_as_float(__builtin_amdgcn_update_dpp(__builtin_amdgcn_update_dpp(0, upi, 0x122, 0xf, 0xf, false), ui, 0x112, 0xf, 0xf, false));
                    }
                    const f32x4 gv = bgv[n] + wg[n][0] * g2 + wg[n][1] * g1 + wg[n][2] * G;
                    const f32x4 uv = buv[n] + wu[n][0] * u2 + wu[n][1] * u1 + wu[n][2] * U;
#pragma unroll
                    for (int j = 0; j < 4; ++j) o[n][j] = gv[j] * __builtin_amdgcn_rcpf(1.f + fexp(-gv[j])) * uv[j];
                }
                u32x4 w; w.x = pk2(o[0][0], o[0][1]); w.y = pk2(o[0][2], o[0][3]); w.z = pk2(o[1][0], o[1][1]); w.w = pk2(o[1][2], o[1][3]);
                *(u32x4*)(ACT + (size_t)row * 2816 + ch0) = w;
                if ((m == 0 && fr < 2) || (m == 3 && fr >= 14)) {
                    bf16_t* dst = (m == 0 ? HF + (size_t)(blk * 2 + fr) * 5632 : HL + (size_t)(blk * 2 + fr - 14) * 5632) + ch0;
                    const f32x4 G0 = acc[ai][0][m][0], G1 = acc[ai][0][m][1], U0 = acc[ai][1][m][0], U1 = acc[ai][1][m][1];
                    u32x4 wgp, wup; wgp.x = pk2(G0[0], G0[1]); wgp.y = pk2(G0[2], G0[3]); wgp.z = pk2(G1[0], G1[1]); wgp.w = pk2(G1[2], G1[3]);
                    wup.x = pk2(U0[0], U0[1]); wup.y = pk2(U0[2], U0[3]); wup.z = pk2(U1[0], U1[1]); wup.w = pk2(U1[2], U1[3]);
                    *(u32x4*)dst = wgp; *(u32x4*)(dst + 2816) = wup;
                }
            }
        }
        return;
    }
    bf16_t* C = (bf16_t*)g.C + (g1 * g.sC1 + g2 * g.sC2);
    const int grow0 = g1 * g.growstep + lrow0;
    const int col0 = u.pn * BM + wc * 32 + 8 * fq;
#pragma unroll
    for (int ai = 0; ai < 2; ++ai)
#pragma unroll
        for (int m = 0; m < 4; ++m) {
            const int lrow = lrow0 + ai * HALF + m * 16, grow = grow0 + ai * HALF + m * 16;
            bf16_t* rowp = C + (size_t)lrow * g.ldc + col0;
            float rs = 1.f;
            if (g.epi == EPI_BF16) { if (g.aux0) rs = g.aux0[grow]; }
            else if (g.epi == EPI_EXPN) { const f32x4 x4 = *(const LAS f32x4*)((LAS float*)(lds + 131072 + 64) + (ai * HALF + wr * 64 + m * 16 + fr) * 4); rs = __builtin_amdgcn_rcpf((x4.x + x4.y) + (x4.z + x4.w)); }
#pragma unroll
            for (int bj = 0; bj < 2; ++bj) {
                f32x4 v0 = acc[ai][bj][m][0], v1 = acc[ai][bj][m][1];
                const int col = col0 + bj * HALF;
                if (g.epi == EPI_EXPN) {
                    const float sc = g.scale * LOG2E;
#pragma unroll
                    for (int j = 0; j < 4; ++j) { v0[j] = fexp2(fminf(v0[j] * sc - 5.77f, 15.9f)) * rs; v1[j] = fexp2(fminf(v1[j] * sc - 5.77f, 15.9f)) * rs; }
                } else if (g.epi == EPI_BF16) {
                    v0 *= rs; v1 *= rs;
                    bool dorope = false; int f0 = 0;
                    if (g.opt == ROPE_SWA) { dorope = col < 1280; f0 = (col & 63) >> 1; }
                    else if (g.opt == ROPE_MLAQ) { const int hc = col % 192; dorope = hc >= 128; f0 = (hc - 128) >> 1; }
                    if (dorope) {
                        const int pos = grow & (SEQ - 1);
                        const f32x4 cs = *(const f32x4*)(g.cosT + pos * 32 + f0), sn = *(const f32x4*)(g.sinT + pos * 32 + f0);
                        f32x4 r0, r1;
                        r0.x = v0.x * cs.x - v0.y * sn.x; r0.y = v0.y * cs.x + v0.x * sn.x;
                        r0.z = v0.z * cs.y - v0.w * sn.y; r0.w = v0.w * cs.y + v0.z * sn.y;
                        r1.x = v1.x * cs.z - v1.y * sn.z; r1.y = v1.y * cs.z + v1.x * sn.z;
                        r1.z = v1.z * cs.w - v1.w * sn.w; r1.w = v1.w * cs.w + v1.z * sn.w;
                        v0 = r0; v1 = r1;
                    }
                } else if (g.epi == EPI_SIG) {
                    const float* bp = (col < 256) ? (g.aux0 + g2 * 256 + col) : (g.aux1 + g2 * 256 + col - 256);
                    const f32x4 b0 = *(const f32x4*)bp, b1 = *(const f32x4*)(bp + 4);
                    v0 += b0; v1 += b1;
#pragma unroll
                    for (int j = 0; j < 4; ++j) { v0[j] = 1.0f / (1.0f + fexp(-v0[j])); v1[j] = 1.0f / (1.0f + fexp(-v1[j])); }
                }
                u32x4 w; w.x = pk2(v0[0], v0[1]); w.y = pk2(v0[2], v0[3]); w.z = pk2(v1[0], v1[1]); w.w = pk2(v1[2], v1[3]);
                *(u32x4*)(rowp + bj * HALF) = w;
            }
        }
}

DI void gemm_phase(const Ctx& cx, LAS unsigned char* lds, const GemmD& g) {
    const int tid = cx.tid, wid = __builtin_amdgcn_readfirstlane(tid >> 6), lane = tid & 63, wr = wid >> 2, wc = wid & 3, fr = lane & 15, fq = lane >> 4;
    const int K = g.K, nt = K / BK;
    const bool PERM = (g.epi != EPI_RES);
    unsigned voffA[2], voffB[2];
#pragma unroll
    for (int i = 0; i < 2; ++i) { int R, C; stage_rc(tid * 16 + i * 8192, R, C); const int Rb = PERM ? ((R & ~31) + perm32(R & 31)) : R;
        voffA[i] = (unsigned)(R * g.lda + C) * 2u; voffB[i] = (unsigned)(Rb * g.ldb + C) * 2u; }
    const size_t kstep = (size_t)(BK * 2);
    const size_t hstepA = (size_t)HALF * g.lda * 2, hstepB = (size_t)HALF * g.ldb * 2;
    const unsigned ldsw = (unsigned)wid * 1024u;
    const int aoff = lds_byte(wr * 64 + fr, fq * 8), boff = lds_byte(wc * 32 + fr, fq * 8);
#define PG8_SA(b, h) (((b) * 2 + (h)) * HTB)
#define PG8_SB(b, h) ((4 + (b) * 2 + (h)) * HTB)
#define PG8_STAGE(bufoff, gbase, voff) do { _Pragma("unroll") for (int _i = 0; _i < 2; ++_i) \
        __builtin_amdgcn_global_load_lds((const unsigned*)((const char*)(gbase) + (voff)[_i]), (LAS unsigned*)(lds + (bufoff) + ldsw + _i * 8192), 16, 0, 0); } while (0)
#define PG8_LDA(dst, b, h) do { _Pragma("unroll") for (int m = 0; m < 4; ++m) _Pragma("unroll") for (int k = 0; k < 2; ++k) dst[m][k] = *(const LAS bf16x8*)(lds + PG8_SA(b, h) + aoff + m * 2048 + k * 1024); } while (0)
#define PG8_LDB(dst, b, h) do { _Pragma("unroll") for (int n = 0; n < 2; ++n) _Pragma("unroll") for (int k = 0; k < 2; ++k) dst[n][k] = *(const LAS bf16x8*)(lds + PG8_SB(b, h) + boff + n * 2048 + k * 1024); } while (0)
#define PG8_MMA(ai, bj, At, Bt) do { __builtin_amdgcn_s_setprio(1); _Pragma("unroll") for (int m = 0; m < 4; ++m) _Pragma("unroll") for (int n = 0; n < 2; ++n) _Pragma("unroll") for (int k = 0; k < 2; ++k) \
        acc[ai][bj][m][n] = __builtin_amdgcn_mfma_f32_16x16x32_f16(__builtin_bit_cast(h16x8, Bt[n][k]), __builtin_bit_cast(h16x8, At[m][k]), acc[ai][bj][m][n], 0, 0, 0); __builtin_amdgcn_s_setprio(0); } while (0)
#define PG8_WAIT_V(n) asm volatile("s_waitcnt vmcnt(" #n ")" ::: "memory")
#define PG8_WAIT_L(n) asm volatile("s_waitcnt lgkmcnt(" #n ")" ::: "memory")
#define PG8_BAR __builtin_amdgcn_s_barrier()
#define PG8_SCHED __builtin_amdgcn_sched_barrier(0)
    Unit cur, nxt; int ui = 0;
    if (!next_unit(cx, g, 0, cur)) return;
    f32x4 acc[2][2][4][2];
#pragma unroll
    for (int a = 0; a < 2; ++a)
#pragma unroll
        for (int b = 0; b < 2; ++b)
#pragma unroll
            for (int m = 0; m < 4; ++m)
#pragma unroll
                for (int n = 0; n < 2; ++n) acc[a][b][m][n] = (f32x4){0.f, 0.f, 0.f, 0.f};
    bf16x8 At[4][2], B0[2][2], B1[2][2];
    const char* cA = (const char*)g.A + 2 * ((cur.g >> g.gshift) * g.sA1 + (cur.g & ((1 << g.gshift) - 1)) * g.sA2 + (long)cur.pm * BM * g.lda);
    const char* cB = (const char*)g.Bt + 2 * ((cur.g >> g.gshift) * g.sB1 + (cur.g & ((1 << g.gshift) - 1)) * g.sB2 + (long)cur.pn * BM * g.ldb);
    PG8_STAGE(PG8_SB(0, 0), cB, voffB); PG8_STAGE(PG8_SB(0, 1), cB + hstepB, voffB); PG8_STAGE(PG8_SA(0, 0), cA, voffA); PG8_STAGE(PG8_SA(0, 1), cA + hstepA, voffA);
    if (wr == 1) PG8_BAR;
    PG8_WAIT_V(2); PG8_BAR;
    PG8_STAGE(PG8_SB(1, 0), cB + kstep, voffB); PG8_STAGE(PG8_SA(1, 0), cA + kstep, voffA); PG8_STAGE(PG8_SB(1, 1), cB + hstepB + kstep, voffB);
    PG8_WAIT_V(6); PG8_BAR;
    for (;;) {
        const bool has_next = next_unit(cx, g, ui + 1, nxt);
        const char* nA = has_next ? (const char*)g.A + 2 * ((nxt.g >> g.gshift) * g.sA1 + (nxt.g & ((1 << g.gshift) - 1)) * g.sA2 + (long)nxt.pm * BM * g.lda) : cA;
        const char* nB = has_next ? (const char*)g.Bt + 2 * ((nxt.g >> g.gshift) * g.sB1 + (nxt.g & ((1 << g.gshift) - 1)) * g.sB2 + (long)nxt.pn * BM * g.ldb) : cB;
        for (int t = 0; t < nt; t += 2) {
            const bool last = (t == nt - 2);
            const char* a1 = cA + (size_t)(t + 1) * kstep;
            const char* a2 = last ? nA : cA + (size_t)(t + 2) * kstep; const char* b2 = last ? nB : cB + (size_t)(t + 2) * kstep;
            const char* a3 = a2 + kstep; const char* b3 = b2 + kstep;
            PG8_LDB(B0, 0, 0); PG8_LDB(B1, 0, 1); PG8_SCHED; PG8_LDA(At, 0, 0); PG8_STAGE(PG8_SA(1, 1), a1 + hstepA, voffA);
            PG8_WAIT_V(8); PG8_WAIT_L(0); PG8_BAR; PG8_MMA(0, 0, At, B0); PG8_MMA(0, 1, At, B1); PG8_BAR; PG8_SCHED;
            PG8_LDA(At, 0, 1); PG8_STAGE(PG8_SB(0, 0), b2, voffB); PG8_STAGE(PG8_SB(0, 1), b2 + hstepB, voffB); PG8_STAGE(PG8_SA(0, 0), a2, voffA);
            PG8_WAIT_V(8); PG8_WAIT_L(0); PG8_BAR; PG8_MMA(1, 0, At, B0); PG8_MMA(1, 1, At, B1); PG8_BAR; PG8_SCHED;
            PG8_LDB(B0, 1, 0); PG8_LDB(B1, 1, 1); PG8_SCHED; PG8_LDA(At, 1, 0); PG8_STAGE(PG8_SA(0, 1), a2 + hstepA, voffA);
            PG8_WAIT_V(8); PG8_WAIT_L(0); PG8_BAR; PG8_MMA(0, 0, At, B0); PG8_MMA(0, 1, At, B1); PG8_BAR; PG8_SCHED;
            PG8_LDA(At, 1, 1); PG8_STAGE(PG8_SB(1, 0), b3, voffB); PG8_STAGE(PG8_SB(1, 1), b3 + hstepB, voffB); PG8_STAGE(PG8_SA(1, 0), a3, voffA);
            PG8_WAIT_V(8); PG8_WAIT_L(0); PG8_BAR; PG8_MMA(1, 0, At, B0); PG8_MMA(1, 1, At, B1); PG8_BAR; PG8_SCHED;
        }
        if (wr == 0) PG8_BAR;
        gemm_epilogue(g, acc, cur, wr, wc, fr, fq, lds);
        if (!has_next) break;
#pragma unroll
        for (int a = 0; a < 2; ++a)
#pragma unroll
            for (int b = 0; b < 2; ++b)
#pragma unroll
                for (int m = 0; m < 4; ++m)
#pragma unroll
                    for (int n = 0; n < 2; ++n) acc[a][b][m][n] = (f32x4){0.f, 0.f, 0.f, 0.f};
        cur = nxt; cA = nA; cB = nB; ++ui;
        if (wr == 1) PG8_BAR;
    }
    PG8_WAIT_V(0);
    PG8_BAR;
#undef PG8_SA
#undef PG8_SB
#undef PG8_STAGE
#undef PG8_LDA
#undef PG8_LDB
#undef PG8_MMA
#undef PG8_WAIT_V
#undef PG8_WAIT_L
#undef PG8_BAR
#undef PG8_SCHED
}

#define MFMA32(a, b, c) __builtin_amdgcn_mfma_f32_32x32x16_f16(__builtin_bit_cast(h16x8, (a)), __builtin_bit_cast(h16x8, (b)), (c), 0, 0, 0)
template <int DN, int DR, int DV, bool RES = false>
DI void attn_block(const Ctx& cx, LAS unsigned char* lds, const bf16_t* Qw, int ldq, const bf16_t* Kb, int ldk, const bf16_t* Krb, int ldkr,
                   const bf16_t* Vb, int ldv, int k_begin, int k_end, int qpos0, int window, float scale2, float m0, float l0, bf16_t* Ow, int ldo) {
    constexpr int DQK = DN + DR, KS = DQK / 16, KSTR = (DQK + 8) * 2, VSTR = (DV == 128 ? 320 : 192), KBYTES = 64 * KSTR, VBYTES = 64 * VSTR, NDT = DV / 32;
    const int tid = cx.tid, lane = tid & 63, h = lane >> 5, c = lane & 31;
    const bool late = __builtin_amdgcn_readfirstlane(tid >> 6) >= 4;
    bf16x8 q[KS];
#pragma unroll
    for (int kk = 0; kk < KS; ++kk) q[kk] = *(const bf16x8*)(Qw + (size_t)c * ldq + 16 * kk + 8 * h);
    f32x16 o[NDT];
#pragma unroll
    for (int dt = 0; dt < NDT; ++dt)
#pragma unroll
        for (int j = 0; j < 16; ++j) o[dt][j] = 0.f;
    float m = m0, l = (h == 0) ? l0 : 0.f;
    constexpr int NCH = DN / 8, NKN = DN / 64, KPI = 512 / NCH;
    constexpr int VCH = DV / 8, NVL = DV / 64, VPI = 512 / VCH;
    u32x4 kreg[NKN], vreg[NVL], rreg;
    const unsigned kgo = (unsigned)(((tid / NCH) * ldk + (tid % NCH) * 8) * 2), klo = (unsigned)((tid / NCH) * KSTR + (tid % NCH) * 16);
    const unsigned vgo = (unsigned)(((tid / VCH) * ldv + (tid % VCH) * 8) * 2), vlo = (unsigned)((tid / VCH) * VSTR + (tid % VCH) * 16);
    const unsigned vrd = (unsigned)((4 * h + ((lane & 15) >> 2)) * VSTR + (16 * ((lane >> 4) & 1) + 4 * (lane & 3)) * 2);
    const unsigned rgo = (unsigned)(((tid >> 3) * ldkr + (tid & 7) * 8) * 2), rlo = (unsigned)((tid >> 3) * KSTR + DN * 2 + (tid & 7) * 16);
    const int ntiles = (k_end - k_begin) >> 6;
#define ATT_GLOAD(k0_) do { const char* kb_ = (const char*)(Kb + (size_t)(k0_) * ldk); const char* vb_ = (const char*)(Vb + (size_t)(k0_) * ldv); \
        _Pragma("unroll") for (int i = 0; i < NKN; ++i) kreg[i] = *(const u32x4*)(kb_ + (size_t)i * KPI * ldk * 2 + kgo); \
        _Pragma("unroll") for (int i = 0; i < NVL; ++i) vreg[i] = *(const u32x4*)(vb_ + (size_t)i * VPI * ldv * 2 + vgo); \
        if (DR > 0) rreg = *(const u32x4*)((const char*)(Krb + (size_t)(k0_) * ldkr) + rgo); } while (0)
#define ATT_LSTORE(kb_, vb_) do { LAS unsigned char* Kt_ = lds + (kb_) * KBYTES; LAS unsigned char* Vt_ = lds + VBASE + (vb_) * VBYTES; \
        _Pragma("unroll") for (int i = 0; i < NKN; ++i) *(LAS u32x4*)(Kt_ + i * KPI * KSTR + klo) = kreg[i]; \
        if (DR > 0) *(LAS u32x4*)(Kt_ + rlo) = rreg; \
        _Pragma("unroll") for (int i = 0; i < NVL; ++i) *(LAS u32x4*)(Vt_ + i * VPI * VSTR + vlo) = vreg[i]; } while (0)
    u32x4 pw[4];
    float alpha = 1.f; bool pend = false;
#define ATT_PV(vb_) do { const LAS unsigned char* Vt = lds + VBASE + (vb_) * VBYTES; \
        _Pragma("unroll") for (int dt = 0; dt < NDT; ++dt) _Pragma("unroll") for (int j = 0; j < 16; ++j) o[dt][j] *= alpha; \
        _Pragma("unroll") for (int ss = 0; ss < 4; ++ss) { const bf16x8 pf = __builtin_bit_cast(bf16x8, pw[ss]); \
            _Pragma("unroll") for (int dt = 0; dt < NDT; ++dt) { \
                LAS unsigned char* vp = (LAS unsigned char*)Vt + vrd + ((ss >> 1) * 32 + 16 * (ss & 1)) * VSTR + dt * 64; \
                const s16x4 lo = __builtin_amdgcn_ds_read_tr16_b64_v4i16((LAS s16x4*)vp), hi = __builtin_amdgcn_ds_read_tr16_b64_v4i16((LAS s16x4*)(vp + 8 * VSTR)); \
                bf16x8 vw; vw[0] = lo[0]; vw[1] = lo[1]; vw[2] = lo[2]; vw[3] = lo[3]; vw[4] = hi[0]; vw[5] = hi[1]; vw[6] = hi[2]; vw[7] = hi[3]; \
                o[dt] = MFMA32(vw, pf, o[dt]); } \
            __builtin_amdgcn_sched_barrier(0); } } while (0)
    constexpr int VBASE = RES ? 4 * KBYTES : 2 * KBYTES;
    if (!RES) { ATT_GLOAD(k_begin); ATT_LSTORE(0, 0); __syncthreads(); }
    int vcur = 0, vprev = 2;
    for (int t = 0; t <= ntiles; ++t) {
        const int k0 = k_begin + 64 * t;
        if (!RES && t + 1 < ntiles) ATT_GLOAD(k0 + 64);
        if (late && pend) { ATT_PV(vprev); pend = false; }
        const bool vis = (t < ntiles) && (k0 <= qpos0 + 31) && (qpos0 - (k0 + 63) < window);
        if (vis) {
            const LAS unsigned char* Kt = lds + (RES ? t : (t & 1)) * KBYTES;
            f32x16 s0, s1;
#pragma unroll
            for (int j = 0; j < 16; ++j) { s0[j] = 0.f; s1[j] = 0.f; }
#pragma unroll
            for (int kk = 0; kk < KS; ++kk) {
                const bf16x8 a0 = *(const LAS bf16x8*)(Kt + c * KSTR + (16 * kk + 8 * h) * 2);
                const bf16x8 a1 = *(const LAS bf16x8*)(Kt + (32 + c) * KSTR + (16 * kk + 8 * h) * 2);
                s0 = MFMA32(a0, q[kk], s0); s1 = MFMA32(a1, q[kk], s1);
                if (kk & 1) __builtin_amdgcn_sched_barrier(0);
            }
            const bool full = (k0 + 63 <= qpos0) && (qpos0 + 31 - k0 < window);
#pragma unroll
            for (int j = 0; j < 16; ++j) { s0[j] *= scale2; s1[j] *= scale2; }
            if (!full) {
                const int dbase = qpos0 + c - k0 - 4 * h;
#pragma unroll
                for (int j = 0; j < 16; ++j) { const int d0 = dbase - (8 * (j >> 2) + (j & 3)), d1 = d0 - 32;
                    if (d0 < 0 || d0 >= window) s0[j] = -INFINITY;
                    if (d1 < 0 || d1 >= window) s1[j] = -INFINITY; }
            }
            float tmax = fmaxf(s0[0], s1[0]);
#pragma unroll
            for (int j = 1; j < 16; ++j) tmax = fmaxf(tmax, fmaxf(s0[j], s1[j]));
            tmax = fmaxf(tmax, __shfl_xor(tmax, 32));
            const float mn = fmaxf(m, tmax); alpha = fexp2(m - mn); m = mn;
            float psum = 0.f;
#pragma unroll
            for (int j = 0; j < 16; ++j) { s0[j] = fexp2(s0[j] - mn); s1[j] = fexp2(s1[j] - mn); psum += s0[j] + s1[j]; }
            l = l * alpha + psum;
#pragma unroll
            for (int s = 0; s < 2; ++s) {
                pw[s].x = pk2(s0[8 * s + 0], s0[8 * s + 1]); pw[s].y = pk2(s0[8 * s + 2], s0[8 * s + 3]); pw[s].z = pk2(s0[8 * s + 4], s0[8 * s + 5]); pw[s].w = pk2(s0[8 * s + 6], s0[8 * s + 7]);
                pw[2 + s].x = pk2(s1[8 * s + 0], s1[8 * s + 1]); pw[2 + s].y = pk2(s1[8 * s + 2], s1[8 * s + 3]); pw[2 + s].z = pk2(s1[8 * s + 4], s1[8 * s + 5]); pw[2 + s].w = pk2(s1[8 * s + 6], s1[8 * s + 7]);
            }
            if (late) pend = true; else ATT_PV(vcur);
        }
        const int vnext = RES ? vcur + 1 : ((vcur == 2) ? 0 : vcur + 1);
        if (!RES && t + 1 < ntiles) ATT_LSTORE((t + 1) & 1, vnext);
        vprev = vcur; vcur = vnext;
        if (!RES) __syncthreads();
    }
    l += __shfl_xor(l, 32);
    const float inv = 1.0f / l;
#pragma unroll
    for (int dt = 0; dt < NDT; ++dt)
#pragma unroll
        for (int jq = 0; jq < 4; ++jq) {
            u32x2 w; w.x = pk2(o[dt][4 * jq] * inv, o[dt][4 * jq + 1] * inv); w.y = pk2(o[dt][4 * jq + 2] * inv, o[dt][4 * jq + 3] * inv);
            *(u32x2*)(Ow + (size_t)c * ldo + dt * 32 + 8 * jq + 4 * h) = w;
        }
#undef ATT_GLOAD
#undef ATT_LSTORE
#undef ATT_PV
}

DI int srccol(int mode, int n) {
    if (mode == 1) return n < 1280 ? ((n & ~63) + ((n & 63) >> 1) + 32 * (n & 1)) : n;
    if (mode == 2) { const int hh = n / 192, j = n % 192; if (j < 128) return n; const int jj = j - 128; return hh * 192 + 128 + (jj >> 1) + 32 * (jj & 1); }
    if (mode == 4) { const int ch = (n >> 8) * 128 + (n & 127); return ((n >> 7) & 1) ? 2816 + ch : ch; }
    if (mode == 3) { if (n < 640) return n; if (n < 704) { const int jj = n - 640; return 640 + (jj >> 1) + 32 * (jj & 1); } return -1; }
    return n;
}
DI void transpose_item(const float* src, int ldsrc, int K, int Nd, int mode, const float* gain, bf16_t* dst, LAS float* scr, int item, int lane) {
    const int nblk = Nd / 32, kb = item / nblk, nb = item % nblk, k0 = 64 * kb, n0 = 32 * nb;
    const int sc0 = srccol(mode, n0 + (lane & 31));
    const int sc = sc0 < 0 ? 0 : sc0; const float msk = sc0 < 0 ? 0.f : 1.f;
    if (mode == 0 || mode == 4) {
        const int scb = srccol(mode, n0) + (lane & 7) * 4;
#pragma unroll
        for (int i = 0; i < 8; ++i) { const int kk = (lane >> 3) + 8 * i; const f32x4 v = *(const f32x4*)(src + (size_t)(k0 + kk) * ldsrc + scb);
            LAS float* d = scr + kk * 33 + (lane & 7) * 4; d[0] = v.x; d[1] = v.y; d[2] = v.z; d[3] = v.w; }
    } else {
#pragma unroll 8
        for (int i = 0; i < 32; ++i) { const int kk = 2 * i + (lane >> 5); scr[kk * 33 + (lane & 31)] = src[(size_t)(k0 + kk) * ldsrc + sc] * msk; }
    }
    LDS_WAIT();
    const int c = lane & 7;
    f32x4 ga = {1.f, 1.f, 1.f, 1.f}, gb = ga;
    if (gain) { ga = *(const f32x4*)(gain + k0 + 8 * c); gb = *(const f32x4*)(gain + k0 + 8 * c + 4); }
#pragma unroll
    for (int j = 0; j < 4; ++j) { const int n = (lane >> 3) + 8 * j; const LAS float* s = scr + (8 * c) * 33 + n;
        u32x4 o; o.x = pk2(s[0 * 33] * ga.x, s[1 * 33] * ga.y); o.y = pk2(s[2 * 33] * ga.z, s[3 * 33] * ga.w); o.z = pk2(s[4 * 33] * gb.x, s[5 * 33] * gb.y); o.w = pk2(s[6 * 33] * gb.z, s[7 * 33] * gb.w);
        *(u32x4*)(dst + (size_t)(n0 + n) * K + k0 + 8 * c) = o; }
    LDS_WAIT();
}
DI void cvt_mat(int gw, int NGW, int lane, LAS float* scr, int& base, const float* src, int ldsrc, int K, int Nd, int mode, const float* gain, bf16_t* dst) {
    const int nitems = (K / 64) * (Nd / 32);
    for (int it = (gw + NGW - (base % NGW)) % NGW; it < nitems; it += NGW) transpose_item(src, ldsrc, K, Nd, mode, gain, dst, scr, it, lane);
    base += nitems;
}
DI void convert_set(const Ctx& cx, const Params& p, int set, LAS unsigned char* lds, int part) {
    const int wid = __builtin_amdgcn_readfirstlane(cx.tid >> 6), lane = cx.tid & 63;
    LAS float* scr = (LAS float*)(lds + wid * 8704);
    const int gw = cx.bid * 8 + wid, NGW = gridDim.x * 8;
    bf16_t* WB = (bf16_t*)(p.ws + WS_WB);
    int base = 0;
    if (set == 9) { cvt_mat(gw, NGW, lane, scr, base, p.in[20], 2048, 1024, 2048, 0, nullptr, (bf16_t*)(p.ws + WS_T)); return; }
    if (part == 1 && set >= 2) cvt_mat(gw, NGW, lane, scr, base, p.in[26] + (size_t)(set - 1) * 2816 * 1024, 1024, 2816, 1024, 0, nullptr, WB + OFF_FD);
    if (set >= 4) return;
    const int L = set, kind = L % 3, mj = L / 3;
    {
    { const f32x4* src4 = (const f32x4*)(p.in[21] + (size_t)L * 1048576); u32x2* dst2 = (u32x2*)(WB + OFF_XQ);
      for (int idx = cx.bid * 512 + cx.tid; idx < 262144; idx += gridDim.x * 512) { const f32x4 v = src4[idx]; u32x2 w; w.x = pk2(v.x, v.y); w.y = pk2(v.z, v.w); dst2[idx] = w; } }
    cvt_mat(gw, NGW, lane, scr, base, p.in[22] + (size_t)L * 1048576, 1024, 1024, 1024, 0, nullptr, WB + OFF_XO);
    cvt_mat(gw, NGW, lane, scr, base, p.in[23] + (size_t)L * 1024 * 5632, 5632, 1024, 5632, 4, nullptr, WB + OFF_FU);
    }
    if (part == 0) cvt_mat(gw, NGW, lane, scr, base, p.in[26] + (size_t)L * 2816 * 1024, 1024, 2816, 1024, 0, nullptr, WB + OFF_FD);
    if (kind == 0) {
        cvt_mat(gw, NGW, lane, scr, base, p.in[4] + (size_t)mj * 1048576, 1024, 1024, 1024, 0, nullptr, WB + OFF_MO);
        cvt_mat(gw, NGW, lane, scr, base, p.in[2] + (size_t)mj * 1024 * 1536, 1536, 1024, 1536, 1, nullptr, WB + OFF_M1);
    } else if (kind == 1) {
        cvt_mat(gw, NGW, lane, scr, base, p.in[13], 1024, 1024, 1024, 0, nullptr, WB + OFF_MO);
        cvt_mat(gw, NGW, lane, scr, base, p.in[5], 2048, 1024, 2048, 0, nullptr, WB + OFF_M1);
#pragma unroll 1
        for (int hh = 0; hh < 4; ++hh) {
            cvt_mat(gw, NGW, lane, scr, base, p.in[8] + (size_t)hh * 65536, 256, 256, 256, 0, nullptr, WB + OFF_M2 + (size_t)(hh * 512) * 256);
            cvt_mat(gw, NGW, lane, scr, base, p.in[10] + (size_t)hh * 65536, 256, 256, 256, 0, nullptr, WB + OFF_M2 + (size_t)(hh * 512 + 256) * 256);
        }
    } else {
        cvt_mat(gw, NGW, lane, scr, base, p.in[19], 1024, 1024, 1024, 0, nullptr, WB + OFF_MO);
        cvt_mat(gw, NGW, lane, scr, base, p.in[14], 704, 1024, 768, 3, nullptr, WB + OFF_M1);
        cvt_mat(gw, NGW, lane, scr, base, p.in[17], 1536, 384, 1536, 2, p.in[15], WB + OFF_M2);
        cvt_mat(gw, NGW, lane, scr, base, p.in[18], 2048, 256, 2048, 0, p.in[16], WB + OFF_M3);
    }
}

DI void setup_phase(const Ctx& cx, const Params& p, LAS unsigned char* lds) {
    const size_t gt = (size_t)cx.bid * 512 + cx.tid, NT = (size_t)gridDim.x * 512;
    float* cosT = (float*)(p.ws + WS_MISC + MS_COS); float* sinT = (float*)(p.ws + WS_MISC + MS_SIN);
    for (size_t idx = gt; idx < (size_t)SEQ * 32; idx += NT) {
        const int pos = (int)(idx >> 5), i = (int)(idx & 31);
        double r = 1.0; for (int k = 0; k < i; ++k) r *= 0.7498942093324559;
        const float inv = (float)r; const float ang = (float)pos * inv;
        const double a = (double)ang * 0.15915494309189535; const double fr = a - __builtin_rint(a);
        const float f = (float)fr;
        cosT[idx] = __builtin_amdgcn_cosf(f); sinT[idx] = __builtin_amdgcn_sinf(f);
    }
    const f32x4* x4 = (const f32x4*)p.in[0]; u32x2* xb = (u32x2*)(p.ws + WS_XB);
    for (size_t idx = gt; idx < (size_t)MTOK * 256; idx += NT) { const f32x4 v = x4[idx]; u32x2 w; w.x = pk2(v.x, v.y); w.y = pk2(v.z, v.w); xb[idx] = w; }
    const f32x4* m4 = (const f32x4*)p.in[1]; u32x2* mb = (u32x2*)(p.ws + WS_MISC + MS_MEMB);
    for (size_t idx = gt; idx < (size_t)1024 * 256; idx += NT) { const f32x4 v = m4[idx]; u32x2 w; w.x = pk2(v.x, v.y); w.y = pk2(v.z, v.w); mb[idx] = w; }
    convert_set(cx, p, 9, lds, 0);
    convert_set(cx, p, 0, lds, 0);
}

DI void ln_phase(const Ctx& cx, const Params& p, int lnidx) {
    const float* g = p.in[27] + lnidx * 1024; const float* b = p.in[28] + lnidx * 1024;
    float* X = p.out; bf16_t* XB = (bf16_t*)(p.ws + WS_XB); f32x2* ST = (f32x2*)(p.ws + WS_MISC + MS_SP);
    const bool final_ln = (lnidx == 11);
    const int wid = __builtin_amdgcn_readfirstlane(cx.tid >> 6), lane = cx.tid & 63, gw = cx.bid * 8 + wid, NGW = gridDim.x * 8;
    f32x4 gv[4], bv[4];
#pragma unroll
    for (int j = 0; j < 4; ++j) { gv[j] = *(const f32x4*)(g + 4 * lane + 256 * j); bv[j] = *(const f32x4*)(b + 4 * lane + 256 * j); }
    for (int row = gw; row < MTOK; row += NGW) {
        f32x4* xr = (f32x4*)(X + (size_t)row * 1024) + lane; f32x4 v[4]; float s = 0.f;
#pragma unroll
        for (int j = 0; j < 4; ++j) { v[j] = xr[64 * j]; s += (v[j].x + v[j].y) + (v[j].z + v[j].w); }
        const float mean = wave_sum(s) * (1.f / 1024.f); float s2 = 0.f;
#pragma unroll
        for (int j = 0; j < 4; ++j) { v[j] = v[j] - mean; s2 += (v[j].x * v[j].x + v[j].y * v[j].y) + (v[j].z * v[j].z + v[j].w * v[j].w); }
        const float rstd = 1.f / sqrtf(wave_sum(s2) * (1.f / 1024.f) + 1e-5f);
        if (lane == 0) ST[row] = (f32x2){mean, rstd};
        u32x2* ob = (u32x2*)(XB + (size_t)row * 1024) + lane;
#pragma unroll
        for (int j = 0; j < 4; ++j) { const f32x4 y = v[j] * rstd * gv[j] + bv[j]; if (final_ln) xr[64 * j] = y; u32x2 w; w.x = pk2(y.x, y.y); w.y = pk2(y.z, y.w); ob[64 * j] = w; }
    }
}

DI void lruconv_phase(const Ctx& cx, const Params& p) {
    const bf16_t* P = (const bf16_t*)(p.ws + WS_T); bf16_t* U = (bf16_t*)(p.ws + WS_T + 128 * MiB);
    const float* cw = p.in[6]; const float* cb = p.in[7];
    const int wid = cx.tid >> 6, lane = cx.tid & 63, gw = cx.bid * 8 + wid, NGW = gridDim.x * 8;
    for (int item = gw; item < 2048; item += NGW) {
        const int rb = item >> 1, c0 = (item & 1) * 512 + lane * 8, row0 = rb * 32;
        const V8 w0 = ldf8(cw + c0), w1 = ldf8(cw + 1024 + c0), w2 = ldf8(cw + 2048 + c0), w3 = ldf8(cw + 3072 + c0), bb = ldf8(cb + c0);
        V8 h3, h2, h1; const f32x4 z = {0.f, 0.f, 0.f, 0.f}; h3.a = z; h3.b = z; h2 = h3; h1 = h3;
        const bf16_t* src = P + (size_t)row0 * 2048 + 1024 + c0;
        if ((row0 & (SEQ - 1)) != 0) { h3 = unpack8(*(const u32x4*)(src - 3 * 2048)); h2 = unpack8(*(const u32x4*)(src - 2 * 2048)); h1 = unpack8(*(const u32x4*)(src - 2048)); }
#pragma unroll 4
        for (int r = 0; r < 32; ++r) {
            const V8 cur = unpack8(*(const u32x4*)(src + (size_t)r * 2048));
            V8 y; y.a = bb.a + w0.a * h3.a + w1.a * h2.a + w2.a * h1.a + w3.a * cur.a; y.b = bb.b + w0.b * h3.b + w1.b * h2.b + w2.b * h1.b + w3.b * cur.b;
            *(u32x4*)(U + (size_t)(row0 + r) * 1024 + c0) = pack8(y);
            h3 = h2; h2 = h1; h1 = cur;
        }
    }
}

DI float neg_expm1(float x) {
    if (x > -0.125f) return -x * (1.f + x * (0.5f + x * (0.16666667f + x * (0.041666668f + x * (0.0083333338f + x * 0.0013888889f)))));
    return 1.f - fexp(x);
}
DI float gelu_tanh(float g) { const float z2 = 1.5957691216057308f * (g + 0.044715f * g * g * g); return g * __builtin_amdgcn_rcpf(1.f + fexp(-z2)); }

constexpr int SCH = 32, NCHK = SEQ / SCH;
template <int PASS>
DI void scan_phase(const Ctx& cx, const Params& p) {
    const bf16_t* P = (const bf16_t*)(p.ws + WS_T); const bf16_t* U = (const bf16_t*)(p.ws + WS_T + 128 * MiB);
    const bf16_t* G = (const bf16_t*)(p.ws + WS_T + 192 * MiB); bf16_t* YB = (bf16_t*)(p.ws + WS_T) + 1024;
    float* SP = (float*)(p.ws + WS_T + 320 * MiB); float* SH = (float*)(p.ws + WS_T + 324 * MiB); float* CR = (float*)(p.ws + WS_T + 328 * MiB);
    const float* lam = p.in[12];
    const int wid = __builtin_amdgcn_readfirstlane(cx.tid >> 6), lane = cx.tid & 63, gw = cx.bid * 8 + wid, NGW = gridDim.x * 8;
    for (int item = gw; item < 4 * NCHK * 4; item += NGW) {
        const int hq = item & 3, chunk = (item >> 2) % NCHK, b = item / (4 * NCHK);
        const int c0 = hq * 256 + lane * 4;
        f32x4 spc;
        { const f32x4 lm = *(const f32x4*)(lam + c0);
#pragma unroll
          for (int e = 0; e < 4; ++e) { const float z = -lm[e]; spc[e] = 8.0f * (fmaxf(z, 0.f) + log1pf(fexp(-fabsf(z)))); } }
        const size_t so = (size_t)(b * NCHK + chunk) * 1024 + c0;
        f32x4 hh = {0.f, 0.f, 0.f, 0.f}, pp = {1.f, 1.f, 1.f, 1.f};
        if (PASS == 2) hh = *(const f32x4*)(CR + so);
        const size_t row0 = (size_t)b * SEQ + chunk * SCH;
#pragma unroll 1
        for (int t0 = 0; t0 < SCH; t0 += 8) {
            u32x2 rw[8], iw[8], uw[8], gw2[8];
#pragma unroll
            for (int t = 0; t < 8; ++t) { const size_t row = row0 + t0 + t;
                rw[t] = *(const u32x2*)(G + row * 2048 + hq * 512 + lane * 4); iw[t] = *(const u32x2*)(G + row * 2048 + hq * 512 + 256 + lane * 4);
                uw[t] = *(const u32x2*)(U + row * 1024 + c0); if (PASS == 2) gw2[t] = *(const u32x2*)(P + row * 2048 + c0); }
#pragma unroll
            for (int t = 0; t < 8; ++t) {
                const f32x4 r = {bf_lo(rw[t].x), bf_hi(rw[t].x), bf_lo(rw[t].y), bf_hi(rw[t].y)}, ig = {bf_lo(iw[t].x), bf_hi(iw[t].x), bf_lo(iw[t].y), bf_hi(iw[t].y)}, uu = {bf_lo(uw[t].x), bf_hi(uw[t].x), bf_lo(uw[t].y), bf_hi(uw[t].y)};
                f32x4 a, bi;
#pragma unroll
                for (int e = 0; e < 4; ++e) { const float la = -spc[e] * r[e]; a[e] = fexp(la); bi[e] = sqrtf(fmaxf(neg_expm1(2.f * la), 0.f)) * (ig[e] * uu[e]); }
                hh = a * hh + bi;
                if (PASS == 1) pp *= a;
                else {
                    const f32x4 gt = {bf_lo(gw2[t].x), bf_hi(gw2[t].x), bf_lo(gw2[t].y), bf_hi(gw2[t].y)};
                    u32x2 w; w.x = pk2(hh.x * gelu_tanh(gt.x), hh.y * gelu_tanh(gt.y)); w.y = pk2(hh.z * gelu_tanh(gt.z), hh.w * gelu_tanh(gt.w));
                    *(u32x2*)(YB + (row0 + t0 + t) * 2048 + c0) = w;
                }
            }
        }
        if (PASS == 1) { *(f32x4*)(SP + so) = pp; *(f32x4*)(SH + so) = hh; }
    }
}
DI void scanmid_phase(const Ctx& cx, const Params& p, LAS unsigned char* lds) {
    if (cx.bid >= 32) return;
    const float* SP = (const float*)(p.ws + WS_T + 320 * MiB); const float* SH = (const float*)(p.ws + WS_T + 324 * MiB); float* CR = (float*)(p.ws + WS_T + 328 * MiB);
    const int b = cx.bid >> 3, cq = cx.tid & 31, seg = cx.tid >> 5, c0 = ((cx.bid & 7) * 32 + cq) * 4;
    LAS f32x4* L = (LAS f32x4*)lds;
    f32x4 A = {1.f, 1.f, 1.f, 1.f}, H = {0.f, 0.f, 0.f, 0.f};
    f32x4 a[16], h0[16];
#pragma unroll
    for (int k = 0; k < 16; ++k) { const size_t o = (size_t)(b * NCHK + seg * 16 + k) * 1024 + c0; a[k] = *(const f32x4*)(SP + o); h0[k] = *(const f32x4*)(SH + o); }
#pragma unroll
    for (int k = 0; k < 16; ++k) { H = a[k] * H + h0[k]; A *= a[k]; }
    L[(cq * 16 + seg) * 2] = A; L[(cq * 16 + seg) * 2 + 1] = H;
    __syncthreads();
    f32x4 hc = {0.f, 0.f, 0.f, 0.f};
    for (int s2 = 0; s2 < seg; ++s2) { const f32x4 As = L[(cq * 16 + s2) * 2], Hs = L[(cq * 16 + s2) * 2 + 1]; hc = As * hc + Hs; }
#pragma unroll
    for (int k = 0; k < 16; ++k) { *(f32x4*)(CR + (size_t)(b * NCHK + seg * 16 + k) * 1024 + c0) = hc; hc = a[k] * hc + h0[k]; }
    __syncthreads();
}

DI void glufix_phase(const Ctx& cx, const Params& p, int layer) {
    bf16_t* ACT = (bf16_t*)(p.ws + WS_T); const bf16_t* HF = (const bf16_t*)(p.ws + WS_T + 176 * MiB); const bf16_t* HL = (const bf16_t*)(p.ws + WS_T + 188 * MiB);
    const float* cw = p.in[24] + (size_t)layer * 3 * 5632; const float* cb = p.in[25] + (size_t)layer * 5632;
    const int total = 512 * 2 * 352;
    for (int idx = cx.bid * 512 + cx.tid; idx < total; idx += gridDim.x * 512) {
        const int c = idx % 352, r = (idx / 352) & 1, blk = idx / 704, col = c * 8, row = blk * 64 + r;
        const bool hasprev = ((blk * 64) & (SEQ - 1)) != 0;
        const u32x4 zz = {0u, 0u, 0u, 0u};
        u32x4 g0r = zz, g1r = zz, u0r = zz, u1r = zz;
        const bf16_t* hf = HF + (size_t)(blk * 2) * 5632 + col;
        if (r == 1) { g1r = *(const u32x4*)hf; u1r = *(const u32x4*)(hf + 2816); }
        if (hasprev) {
            const bf16_t* hl = HL + (size_t)((blk - 1) * 2) * 5632 + col;
            if (r == 1) { g0r = *(const u32x4*)(hl + 5632); u0r = *(const u32x4*)(hl + 5632 + 2816); }
            else { g0r = *(const u32x4*)hl; u0r = *(const u32x4*)(hl + 2816); g1r = *(const u32x4*)(hl + 5632); u1r = *(const u32x4*)(hl + 5632 + 2816); }
        }
        const u32x4 gcr = *(const u32x4*)(hf + (size_t)r * 5632), ucr = *(const u32x4*)(hf + (size_t)r * 5632 + 2816);
        const V8 g0 = ldf8(cw + col), g1 = ldf8(cw + 5632 + col), g2 = ldf8(cw + 2 * 5632 + col), gb = ldf8(cb + col);
        const V8 u0 = ldf8(cw + 2816 + col), u1 = ldf8(cw + 5632 + 2816 + col), u2 = ldf8(cw + 2 * 5632 + 2816 + col), ub = ldf8(cb + 2816 + col);
        const V8 gh2 = unpack8(g0r), gh1 = unpack8(g1r), gc = unpack8(gcr), uh2 = unpack8(u0r), uh1 = unpack8(u1r), uc = unpack8(ucr);
        V8 gv, uv, o;
        gv.a = gb.a + g0.a * gh2.a + g1.a * gh1.a + g2.a * gc.a; gv.b = gb.b + g0.b * gh2.b + g1.b * gh1.b + g2.b * gc.b;
        uv.a = ub.a + u0.a * uh2.a + u1.a * uh1.a + u2.a * uc.a; uv.b = ub.b + u0.b * uh2.b + u1.b * uh1.b + u2.b * uc.b;
#pragma unroll
        for (int e = 0; e < 4; ++e) { o.a[e] = gv.a[e] * __builtin_amdgcn_rcpf(1.f + fexp(-gv.a[e])) * uv.a[e]; o.b[e] = gv.b[e] * __builtin_amdgcn_rcpf(1.f + fexp(-gv.b[e])) * uv.b[e]; }
        *(u32x4*)(ACT + (size_t)row * 2816 + col) = pack8(o);
    }
}

DI void mlaprep_phase(const Ctx& cx, const Params& p) {
    const bf16_t* Cc = (const bf16_t*)(p.ws + WS_T); bf16_t* KR = (bf16_t*)(p.ws + WS_T + 272 * MiB);
    float* rsq = (float*)(p.ws + WS_MISC + MS_RSQ); float* rskv = (float*)(p.ws + WS_MISC + MS_RSKV);
    const float* cosT = (const float*)(p.ws + WS_MISC + MS_COS); const float* sinT = (const float*)(p.ws + WS_MISC + MS_SIN);
    const int wid = cx.tid >> 6, lane = cx.tid & 63, gw = cx.bid * 8 + wid, NGW = gridDim.x * 8;
    for (int row = gw; row < MTOK; row += NGW) {
        const bf16_t* src = Cc + (size_t)row * 768;
        const V8 v0 = unpack8(*(const u32x4*)(src + 8 * lane));
        const float ss0 = ((v0.a.x * v0.a.x + v0.a.y * v0.a.y) + (v0.a.z * v0.a.z + v0.a.w * v0.a.w)) + ((v0.b.x * v0.b.x + v0.b.y * v0.b.y) + (v0.b.z * v0.b.z + v0.b.w * v0.b.w));
        float sq = (lane < 48) ? ss0 : 0.f, skv = (lane < 48) ? 0.f : ss0;
        if (lane < 32) {
            const V8 v1 = unpack8(*(const u32x4*)(src + 512 + 8 * lane));
            if (lane < 16) skv += ((v1.a.x * v1.a.x + v1.a.y * v1.a.y) + (v1.a.z * v1.a.z + v1.a.w * v1.a.w)) + ((v1.b.x * v1.b.x + v1.b.y * v1.b.y) + (v1.b.z * v1.b.z + v1.b.w * v1.b.w));
            else if (lane < 24) {
                const int pos = row & (SEQ - 1), f0 = 4 * (lane - 16);
                const f32x4 cs = *(const f32x4*)(cosT + pos * 32 + f0), sn = *(const f32x4*)(sinT + pos * 32 + f0);
                V8 r;
                r.a.x = v1.a.x * cs.x - v1.a.y * sn.x; r.a.y = v1.a.y * cs.x + v1.a.x * sn.x;
                r.a.z = v1.a.z * cs.y - v1.a.w * sn.y; r.a.w = v1.a.w * cs.y + v1.a.z * sn.y;
                r.b.x = v1.b.x * cs.z - v1.b.y * sn.z; r.b.y = v1.b.y * cs.z + v1.b.x * sn.z;
                r.b.z = v1.b.z * cs.w - v1.b.w * sn.w; r.b.w = v1.b.w * cs.w + v1.b.z * sn.w;
                *(u32x4*)(KR + (size_t)row * 64 + 8 * (lane - 16)) = pack8(r);
            }
        }
        sq = wave_sum(sq); skv = wave_sum(skv);
        if (lane == 0) { rsq[row] = 1.f / sqrtf(sq * (1.f / 384.f) + 1e-6f); rskv[row] = 1.f / sqrtf(skv * (1.f / 256.f) + 1e-6f); }
    }
}

DI void swa_phase(const Ctx& cx, const Params& p, int mj, LAS unsigned char* lds) {
    const bf16_t* QKV = (const bf16_t*)(p.ws + WS_T); bf16_t* AO = (bf16_t*)(p.ws + WS_T + 96 * MiB);
    const float* sinks = p.in[3] + mj * 16;
    const int tid = cx.tid, wid = __builtin_amdgcn_readfirstlane(tid >> 6);
    constexpr int KSTR = 144, KBYTES = 64 * KSTR, VSTR = 192, VBYTES = 64 * VSTR;
    for (int item = cx.bid; item < 1024; item += gridDim.x) {
        const int n = item & 63, kvh = (item >> 6) & 3, b = item >> 8;
        const size_t rowbase = (size_t)b * SEQ;
        const bf16_t* Kb = QKV + rowbase * 1536 + 1024 + kvh * 64; const bf16_t* Vb = QKV + rowbase * 1536 + 1280 + kvh * 64;
        const int k_begin = (n > 0 ? n - 1 : 0) * 128, k_end = (n + 1) * 128, nkeys = k_end - k_begin;
        u32x4 kr[4], vr[4];
#pragma unroll
        for (int i = 0; i < 4; ++i) { const int ci = tid + 512 * i, key = ci >> 3, part = ci & 7;
            if (key < nkeys) { kr[i] = *(const u32x4*)(Kb + (size_t)(k_begin + key) * 1536 + part * 8); vr[i] = *(const u32x4*)(Vb + (size_t)(k_begin + key) * 1536 + part * 8); } }
#pragma unroll
        for (int i = 0; i < 4; ++i) { const int ci = tid + 512 * i, key = ci >> 3, part = ci & 7;
            if (key < nkeys) { *(LAS u32x4*)(lds + (key >> 6) * KBYTES + (key & 63) * KSTR + part * 16) = kr[i]; *(LAS u32x4*)(lds + 4 * KBYTES + (key >> 6) * VBYTES + (key & 63) * VSTR + part * 16) = vr[i]; } }
        __syncthreads();
        const int qpos0 = n * 128 + (wid & 3) * 32;
#pragma unroll 1
        for (int half = 0; half < 2; ++half) {
            const int head = kvh * 4 + half * 2 + (wid >> 2);
            attn_block<64, 0, 64, true>(cx, lds, QKV + (rowbase + qpos0) * 1536 + head * 64, 1536, Kb, 1536, Kb, 1536, Vb, 1536, k_begin, k_end, qpos0, 128, 0.125f * LOG2E, sinks[head] * LOG2E, 1.0f,
                                        AO + (rowbase + qpos0) * 1024 + head * 64, 1024);
        }
        __syncthreads();
    }
}
DI void mla_phase(const Ctx& cx, const Params& p, LAS unsigned char* lds) {
    const bf16_t* Qm = (const bf16_t*)(p.ws + WS_T + 48 * MiB); const bf16_t* KV = (const bf16_t*)(p.ws + WS_T + 144 * MiB);
    const bf16_t* KR = (const bf16_t*)(p.ws + WS_T + 272 * MiB); bf16_t* AO = (bf16_t*)(p.ws + WS_T + 276 * MiB);
    const int wid = __builtin_amdgcn_readfirstlane(cx.tid >> 6);
    for (int pid0 = cx.bid; pid0 < 512; pid0 += gridDim.x) {
        const int pid = (gridDim.x == 256) ? ((pid0 & ~255) + (pid0 & 7) * 32 + ((pid0 & 255) >> 3)) : pid0;
        const int bh = pid >> 4, qa = pid & 15, b = bh >> 3, hd = bh & 7;
        const size_t rowbase = (size_t)b * SEQ;
#pragma unroll 1
        for (int sub = 0; sub < 2; ++sub) {
            const int qt = sub ? 31 - qa : qa, qpos0 = qt * 256 + wid * 32;
            attn_block<128, 64, 128>(cx, lds, Qm + (rowbase + qpos0) * 1536 + hd * 192, 1536, KV + rowbase * 2048 + hd * 256, 2048, KR + rowbase * 64, 64,
                                     KV + rowbase * 2048 + hd * 256 + 128, 2048, 0, (qt + 1) * 256, qpos0, 0x40000000, 0.07216878364870322f * LOG2E, -1e30f, 0.f,
                                     AO + (rowbase + qpos0) * 1024 + hd * 128, 1024);
        }
    }
}


#define XB_TMO      128
#define XB_XCNT(j)  (256  + 64 * (j))
#define XB_XSUB(j)  (1280 + 64 * (j))
#define XB_XGEN(j)  (2304 + 64 * (j))
#define XB_TOP      3328
#define XB_TOPGEN   3392
#define XCD_BAR_WORDS 3456
#define XB_SPIN_CAP (1u << 18)
DI unsigned xb_ld(unsigned* p)              { return __hip_atomic_load(p, __ATOMIC_RELAXED, __HIP_MEMORY_SCOPE_AGENT); }
DI unsigned xb_add(unsigned* p, unsigned v) { return __hip_atomic_fetch_add(p, v, __ATOMIC_RELAXED, __HIP_MEMORY_SCOPE_AGENT); }
DI unsigned xb_xcc_id() { return (unsigned)__builtin_amdgcn_s_getreg((3 << 11) | 20) & 0xFu; }
#define XB_SPIN(cond, bar) do { unsigned _sp = 0; while (cond) { __builtin_amdgcn_s_sleep(1); \
    if ((++_sp & 255u) == 0u) { if (xb_ld(&(bar)[XB_TMO])) break; if (_sp > XB_SPIN_CAP) { atomicAdd(&(bar)[XB_TMO], 1u); break; } } } } while (0)
struct XcdBarrier { unsigned* bar; unsigned x; volatile LAS unsigned* st; };
DI XcdBarrier xcd_barrier_post(unsigned* bar, volatile LAS unsigned* st) {
    XcdBarrier b; b.bar = bar; b.x = xb_xcc_id(); b.st = st;
    if (threadIdx.x == 0) (void)xb_add(&bar[XB_XCNT(b.x)], 1u);
    return b;
}
DI void xcd_barrier_complete(unsigned* bar, unsigned x, unsigned& nloc, unsigned& nx) {
    const unsigned G = gridDim.x * gridDim.y * gridDim.z;
    unsigned sum, cnt, mine, sp = 0u;
    for (;;) {
        sum = 0u; cnt = 0u; mine = 0u;
#pragma unroll
        for (unsigned j = 0; j < 16; ++j) { const unsigned c = xb_ld(&bar[XB_XCNT(j)]); sum += c; cnt += (c > 0u) ? 1u : 0u; mine = (j == x) ? c : mine; }
        if (sum == G) break;
        __builtin_amdgcn_s_sleep(1);
        if ((++sp & 255u) == 0u) { if (xb_ld(&bar[XB_TMO])) break; if (sp > XB_SPIN_CAP) { atomicAdd(&bar[XB_TMO], 1u); break; } }
    }
    nloc = mine > 0u ? mine : 1u; nx = cnt > 0u ? cnt : 1u;
}
DI void xcd_barrier(const XcdBarrier& b) {
    asm volatile("s_waitcnt vmcnt(0)" ::: "memory");
    __syncthreads();
    if (threadIdx.x == 0) {
        unsigned* bar = b.bar;
        __builtin_amdgcn_s_waitcnt(0);
        unsigned nloc = b.st[0], nx = b.st[1];
        if (nloc == 0u) { xcd_barrier_complete(bar, b.x, nloc, nx); b.st[0] = nloc; b.st[1] = nx; }
        const unsigned old = xb_add(&bar[XB_XSUB(b.x)], 1u);
        const unsigned gen = old / nloc;
        if (old + 1u == (gen + 1u) * nloc) {
            __builtin_amdgcn_fence(__ATOMIC_RELEASE, "agent");
            asm volatile("s_waitcnt vmcnt(0)" ::: "memory");
            const unsigned og = xb_add(&bar[XB_TOP], 1u);
            const unsigned tg = og / nx;
            if (og + 1u == (tg + 1u) * nx) xb_add(&bar[XB_TOPGEN], 1u);
            else XB_SPIN(xb_ld(&bar[XB_TOPGEN]) == tg, bar);
            __builtin_amdgcn_fence(__ATOMIC_ACQUIRE, "agent");
            xb_add(&bar[XB_XGEN(b.x)], 1u);
            asm volatile("s_waitcnt vmcnt(0)" ::: "memory");
        } else {
            XB_SPIN(xb_ld(&bar[XB_XGEN(b.x)]) == gen, bar);
            __builtin_amdgcn_fence(__ATOMIC_ACQUIRE, "agent");
            asm volatile("s_waitcnt vmcnt(0)" ::: "memory");
        }
    }
    __syncthreads();
}

enum { K_SETUP = 0, K_GEMM, K_SWA, K_MLA, K_LN, K_LRUCONV, K_SCAN1, K_SCAN2, K_GLU, K_MLAPREP, K_DUMP, K_SCANMID };
struct PhaseD { int kind, nosync, layer, arg; GemmD g; };

DI void gd_init(GemmD& g, const void* A, int lda, const void* Bt, int ldb, int M, int N, int K, int epi, void* C, int ldc) {
    g.A = (const bf16_t*)A; g.Bt = (const bf16_t*)Bt; g.lda = lda; g.ldb = ldb; g.M = M; g.N = N; g.K = K; g.G = 1;
    g.sA1 = g.sA2 = g.sB1 = g.sB2 = g.sC1 = g.sC2 = 0; g.epi = epi; g.opt = ROPE_NONE; g.ldc = ldc; g.growstep = 0; g.gshift = 2; g.rot = 0; g.C = C; g.aux0 = nullptr; g.aux1 = nullptr; g.scale = 1.f;
}
#define RES_PREV(sidx) do { const int s_ = (sidx); if (s_ == 0) d.g.aux1 = p.in[0]; d.g.aux0 = (const float*)(MS + MS_SP); d.g.opt = 32 * (s_ + 1); d.g.cosT = p.in[27] + s_ * 1024; d.g.sinT = p.in[28] + s_ * 1024; } while (0)
DI void make_desc(const Params& p, int ph, PhaseD& d) {
    unsigned char* ws = p.ws; unsigned char* T = ws + WS_T; unsigned char* MS = ws + WS_MISC;
    bf16_t* WB = (bf16_t*)(ws + WS_WB); bf16_t* XB = (bf16_t*)(ws + WS_XB);
    d.kind = K_SETUP; d.nosync = 0; d.layer = 0; d.arg = 0;
    gd_init(d.g, XB, 1024, WB, 1024, MTOK, 1024, 1024, EPI_BF16, T, 1024);
    d.g.cosT = (const float*)(MS + MS_COS); d.g.sinT = (const float*)(MS + MS_SIN);
    if (ph == 0) return;
    if (ph == 1) { d.kind = K_GEMM; gd_init(d.g, MS + MS_MEMB, 1024, T, 1024, 1024, 1024, 1024, EPI_BF16, MS + MS_KMEM, 1024); return; }
    if (ph == 2) { d.kind = K_GEMM; d.nosync = 1; gd_init(d.g, MS + MS_MEMB, 1024, T + 2 * MiB, 1024, 1024, 1024, 1024, EPI_BF16, MS + MS_VT, 1024); d.g.rot = 16; return; }
    int q = ph - 3, layer = 0;
    for (;;) { const int k3 = layer % 3, cnt = (k3 == 0 ? 5 : (k3 == 1 ? 9 : 8)) + 5; if (q < cnt) break; q -= cnt; ++layer; }
    const int kind = layer % 3, nm = (kind == 0 ? 5 : (kind == 1 ? 9 : 8));
    d.layer = layer;
    if (q == 1) {
        d.kind = K_GEMM; d.nosync = 1; gd_init(d.g, MS + MS_KMEM, 1024, WB + OFF_XQ, 1024, 256, 1024, 256, EPI_BF16, T + 384 * MiB, 1024);
        d.g.G = 16; d.g.sA1 = 256 * 1024; d.g.sA2 = 256; d.g.sB1 = 0; d.g.sB2 = 256; d.g.sC1 = 1024 * 1024; d.g.sC2 = 256 * 1024; d.g.rot = 192; return; }
    if (q == 2) {
        d.kind = K_GEMM; d.nosync = 1; gd_init(d.g, WB + OFF_XO, 1024, MS + MS_VT, 1024, 1024, 256, 256, EPI_BF16, T + 392 * MiB, 1024);
        d.g.G = 16; d.g.sA1 = 0; d.g.sA2 = 256; d.g.sB1 = 256 * 1024; d.g.sB2 = 256; d.g.sC1 = 1024 * 1024; d.g.sC2 = 256; d.g.rot = 128; return; }
    if (q < nm) {
        if (q > 2) q -= 2;
        if (kind == 0) {
            if (q == 0) { d.kind = K_GEMM; gd_init(d.g, XB, 1024, WB + OFF_M1, 1024, MTOK, 1536, 1024, EPI_BF16, T, 1536); d.g.opt = ROPE_SWA; }
            else if (q == 1) { d.kind = K_SWA; }
            else if (q == 2) { d.kind = K_GEMM; gd_init(d.g, T + 96 * MiB, 1024, WB + OFF_MO, 1024, MTOK, 1024, 1024, EPI_RES, p.out, 1024); RES_PREV(layer * 3 + 0); }
            else { d.kind = K_LN; d.arg = layer * 3 + 0; }
        } else if (kind == 1) {
            if (q == 0) { d.kind = K_GEMM; gd_init(d.g, XB, 1024, WB + OFF_M1, 1024, MTOK, 2048, 1024, EPI_BF16, T, 2048); }
            else if (q == 1) { d.kind = K_LRUCONV; }
            else if (q == 2) { d.kind = K_GEMM; gd_init(d.g, T + 128 * MiB, 1024, WB + OFF_M2, 256, MTOK, 512, 256, EPI_SIG, T + 192 * MiB, 2048);
                               d.g.G = 4; d.g.sA2 = 256; d.g.sB2 = 512 * 256; d.g.sC2 = 512; d.g.aux0 = p.in[9]; d.g.aux1 = p.in[11]; }
            else if (q == 3) { d.kind = K_SCAN1; }
            else if (q == 4) { d.kind = K_SCANMID; }
            else if (q == 5) { d.kind = K_SCAN2; }
            else if (q == 6) { d.kind = K_GEMM; gd_init(d.g, (bf16_t*)T + 1024, 2048, WB + OFF_MO, 1024, MTOK, 1024, 1024, EPI_RES, p.out, 1024); RES_PREV(layer * 3 + 0); }
            else { d.kind = K_LN; d.arg = layer * 3 + 0; }
        } else {
            if (q == 0) { d.kind = K_GEMM; gd_init(d.g, XB, 1024, WB + OFF_M1, 1024, MTOK, 768, 1024, EPI_BF16, T, 768); }
            else if (q == 1) { d.kind = K_MLAPREP; }
            else if (q == 2) { d.kind = K_GEMM; gd_init(d.g, T, 768, WB + OFF_M2, 384, MTOK, 1536, 384, EPI_BF16, T + 48 * MiB, 1536); d.g.opt = ROPE_MLAQ; d.g.aux0 = (const float*)(MS + MS_RSQ); }
            else if (q == 3) { d.kind = K_GEMM; d.nosync = 1; gd_init(d.g, (bf16_t*)T + 384, 768, WB + OFF_M3, 256, MTOK, 2048, 256, EPI_BF16, T + 144 * MiB, 2048); d.g.aux0 = (const float*)(MS + MS_RSKV); }
            else if (q == 4) { d.kind = K_MLA; }
            else if (q == 5) { d.kind = K_GEMM; gd_init(d.g, T + 276 * MiB, 1024, WB + OFF_MO, 1024, MTOK, 1024, 1024, EPI_RES, p.out, 1024); RES_PREV(layer * 3 + 0); }
            else { d.kind = K_LN; d.arg = layer * 3 + 0; }
        }
        return;
    }
    q -= nm;
    if (q < 2) {
        if (q == 0) { d.kind = K_GEMM; gd_init(d.g, XB, 1024, T + 384 * MiB, 1024, SEQ, 1024, 1024, EPI_EXPN, T, 1024);
                      d.g.G = 4; d.g.gshift = 0; d.g.sA1 = (long)SEQ * 1024; d.g.sB1 = 1024 * 1024; d.g.sC1 = (long)SEQ * 1024; d.g.growstep = SEQ; d.g.scale = 0.0625f; }
        else if (q == 1) { d.kind = K_GEMM; gd_init(d.g, T, 1024, T + 392 * MiB, 1024, SEQ, 1024, 1024, EPI_RES, p.out, 1024);
                           d.g.G = 4; d.g.gshift = 0; d.g.sA1 = (long)SEQ * 1024; d.g.sB1 = 1024 * 1024; d.g.growstep = SEQ; RES_PREV(layer * 3 + 1); }
        return;
    }
    q -= 2;
    if (q == 0) { d.kind = K_GEMM; gd_init(d.g, XB, 1024, WB + OFF_FU, 1024, MTOK, 5632, 1024, EPI_GLU, T, 2816);
                  d.g.aux0 = p.in[24] + (size_t)layer * 3 * 5632; d.g.aux1 = p.in[25] + (size_t)layer * 5632; d.g.cosT = (const float*)(T + 176 * MiB); d.g.sinT = (const float*)(T + 188 * MiB); }
    else if (q == 1) { d.kind = K_GLU; }
    else if (q == 2) { d.kind = K_GEMM; gd_init(d.g, T, 2816, WB + OFF_FD, 2816, MTOK, 1024, 2816, EPI_RES, p.out, 1024); RES_PREV(layer * 3 + 2); }
    else { d.kind = K_LN; d.arg = layer * 3 + 2; }
}

__global__ void __launch_bounds__(512) mega(Params p_) {
    extern __shared__ __attribute__((aligned(16))) unsigned char smem[];
    LAS unsigned char* lds = (LAS unsigned char*)smem;
    cg::grid_group grid = cg::this_grid();
    const int ph_lo = p_.ph_lo, ph_hi = p_.ph_hi;
    volatile LAS unsigned* bst = (volatile LAS unsigned*)(lds + 131072);
    if (threadIdx.x == 0) { bst[0] = 0u; bst[1] = 0u; }
    __syncthreads();
    const XcdBarrier xb = xcd_barrier_post((unsigned*)(p_.ws + WS_MISC + MS_BAR), bst);
    for (int it_ = ph_lo; it_ < ph_hi; ++it_) {
#ifdef REP_PH
        const int ph = (it_ > REP_PH) ? it_ - 1 : it_;
#else
        const int ph = it_;
#endif
        int zero; asm volatile("s_mov_b32 %0, 0" : "=s"(zero));
        Ctx cx; cx.tid = threadIdx.x; cx.bid = blockIdx.x; asm volatile("" : "+v"(cx.tid)); asm volatile("" : "+s"(cx.bid));
        const Params& p = *(const Params*)((const char*)&p_ + zero);
        PhaseD d; make_desc(p, ph, d);
        if (it_ > ph_lo && !d.nosync) { if (ph_hi < 0) grid.sync(); else xcd_barrier(xb); }
        switch (d.kind) {
            case K_SETUP: setup_phase(cx, p, lds); break;
            case K_GEMM: gemm_phase(cx, lds, d.g); break;
            case K_SWA: swa_phase(cx, p, d.layer / 3, lds); break;
            case K_MLA: mla_phase(cx, p, lds); break;
            case K_LRUCONV: lruconv_phase(cx, p); break;
            case K_SCAN1: scan_phase<1>(cx, p); break;
            case K_SCAN2: scan_phase<2>(cx, p); break;
            case K_SCANMID: scanmid_phase(cx, p, lds); break;
            case K_GLU: glufix_phase(cx, p, d.layer); convert_set(cx, p, d.layer + 1, lds, 1); break;
            case K_MLAPREP: mlaprep_phase(cx, p); break;
            default: break;
        }
    }
}

extern "C" void kernel_launch(void* const* d_in, const int* in_sizes, int n_in, void* d_out, int out_size, void* d_ws, size_t ws_size, hipStream_t stream) {
    static int grid = 0;
    if (grid == 0) {
        if (n_in != 29 || ws_size < WS_NEED) { fprintf(stderr, "kernel_launch: unexpected n_in %d / ws_size %zu\n", n_in, ws_size); grid = -1; return; }
        int dev = 0, cus = 0, per_cu = 0;
        hipGetDevice(&dev);
        hipDeviceGetAttribute(&cus, hipDeviceAttributeMultiprocessorCount, dev);
        if (hipFuncSetAttribute((const void*)mega, hipFuncAttributeMaxDynamicSharedMemorySize, LDS_BYTES) != hipSuccess) { fprintf(stderr, "kernel_launch: hipFuncSetAttribute failed\n"); }
        if (hipOccupancyMaxActiveBlocksPerMultiprocessor(&per_cu, (const void*)mega, 512, LDS_BYTES) != hipSuccess || per_cu < 1) { fprintf(stderr, "kernel_launch: occupancy query gave %d\n", per_cu); per_cu = 1; }
        (void)hipGetLastError();
        grid = cus * per_cu;
        if (grid > 256) grid = 256;
    }
    if (grid < 0) return;
    (void)hipMemsetAsync((unsigned char*)d_ws + WS_MISC + MS_BAR, 0, 16384 + 32768, stream);
    Params p{};
    for (int i = 0; i < 29; ++i) p.in[i] = (const float*)d_in[i];
    p.out = (float*)d_out; p.ws = (unsigned char*)d_ws;
#if MULTI_LAUNCH
    for (int ph = 0; ph < NPHASES; ++ph) { p.ph_lo = ph; p.ph_hi = ph + 1; hipLaunchKernelGGL(mega, dim3(grid), dim3(512), LDS_BYTES, stream, p); }
#else
#ifdef REP_PH
    p.ph_lo = 0; p.ph_hi = NPHASES + 1;
#else
    p.ph_lo = 0; p.ph_hi = NPHASES;
#endif
    void* args[] = {&p};
    hipError_t e = hipLaunchCooperativeKernel((const void*)mega, dim3(grid), dim3(512), args, LDS_BYTES, stream);
    if (e != hipSuccess) fprintf(stderr, "cooperative launch failed: %s (grid %d)\n", hipGetErrorString(e), grid);
#endif
}
```

```cpp
#include <hip/hip_runtime.h>
#include <hip/hip_cooperative_groups.h>
#include <cstdio>
#include <cstdint>
namespace cg = cooperative_groups;

#ifndef MULTI_LAUNCH
#define MULTI_LAUNCH 0
#endif

#define LAS __attribute__((address_space(3)))
#define DI __device__ __forceinline__
typedef unsigned short bf16_t;
typedef short bf16x8 __attribute__((ext_vector_type(8)));
typedef short s16x4 __attribute__((ext_vector_type(4)));
typedef float f32x2 __attribute__((ext_vector_type(2)));
typedef float f32x4 __attribute__((ext_vector_type(4)));
typedef float f32x16 __attribute__((ext_vector_type(16)));
typedef unsigned u32x2 __attribute__((ext_vector_type(2)));
typedef unsigned u32x4 __attribute__((ext_vector_type(4)));
typedef _Float16 h16x2 __attribute__((ext_vector_type(2)));
typedef _Float16 h16x8 __attribute__((ext_vector_type(8)));

constexpr int SEQ = 8192, MTOK = 32768;
constexpr float ALPHA_F = 1.6817928305074290f;
constexpr float LOG2E = 1.4426950408889634f;
constexpr size_t MiB = (size_t)1 << 20;
constexpr int LDS_BYTES = 131072 + 64 + 10240 + 64;
constexpr int NPHASES = 50;
constexpr size_t WS_WB = 0, WS_MISC = 32 * MiB, WS_XB = 48 * MiB, WS_T = 112 * MiB, WS_NEED = 512 * MiB;
constexpr size_t OFF_M1 = 0, OFF_M2 = (size_t)2 << 20, OFF_M3 = (size_t)3 << 20, OFF_MO = (size_t)4 << 20, OFF_XQ = (size_t)5 << 20,
                 OFF_XO = (size_t)6 << 20, OFF_FU = (size_t)7 << 20, OFF_FD = (size_t)13 << 20;
constexpr size_t MS_COS = 0, MS_SIN = 1 * MiB, MS_MEMB = 2 * MiB, MS_KMEM = 4 * MiB, MS_VT = 6 * MiB, MS_RSQ = 8 * MiB, MS_RSKV = 8 * MiB + 131072,
                 MS_XSUM = 9 * MiB, MS_SP = 11 * MiB, MS_SH = 12 * MiB, MS_BAR = 14 * MiB;

struct Params { const float* in[29]; float* out; unsigned char* ws; int ph_lo, ph_hi; };
struct Ctx { int tid, bid; };

DI unsigned pk2(float a, float b) { f32x2 v = {a, b}; h16x2 r = __builtin_convertvector(v, h16x2); return __builtin_bit_cast(unsigned, r); }
DI float bf_lo(unsigned w) { return (float)__builtin_bit_cast(h16x2, w)[0]; }
DI float bf_hi(unsigned w) { return (float)__builtin_bit_cast(h16x2, w)[1]; }
DI float fexp2(float x) { return __builtin_amdgcn_exp2f(x); }
DI float fexp(float x) { return __builtin_amdgcn_exp2f(x * LOG2E); }
struct V8 { f32x4 a, b; };
DI V8 unpack8(u32x4 w) { V8 r; r.a = (f32x4){bf_lo(w.x), bf_hi(w.x), bf_lo(w.y), bf_hi(w.y)}; r.b = (f32x4){bf_lo(w.z), bf_hi(w.z), bf_lo(w.w), bf_hi(w.w)}; return r; }
DI u32x4 pack8(const V8& v) { u32x4 w; w.x = pk2(v.a.x, v.a.y); w.y = pk2(v.a.z, v.a.w); w.z = pk2(v.b.x, v.b.y); w.w = pk2(v.b.z, v.b.w); return w; }
DI V8 ldf8(const float* p) { V8 r; r.a = *(const f32x4*)p; r.b = *(const f32x4*)(p + 4); return r; }
DI float wave_sum(float v) {
#pragma unroll
    for (int o = 1; o < 64; o <<= 1) v += __shfl_xor(v, o);
    return v;
}
#define LDS_WAIT() asm volatile("s_waitcnt lgkmcnt(0)" ::: "memory")

constexpr int BM = 256, BK = 64, HALF = 128, HTB = HALF * BK * 2;
enum { EPI_BF16 = 0, EPI_RES = 1, EPI_SIG = 2, EPI_EXP = 3, EPI_DIV = 4, EPI_GLU = 5, EPI_EXPN = 6 };
constexpr size_t MS_CNT = 14 * MiB + 16384;
enum { ROPE_NONE = 0, ROPE_SWA = 1, ROPE_MLAQ = 2 };
struct GemmD {
    const bf16_t* A; const bf16_t* Bt; int lda, ldb, M, N, K, G;
    long sA1, sA2, sB1, sB2, sC1, sC2;
    int epi, opt, ldc, growstep, gshift, rot;
    void* C; const float* aux0; const float* aux1; const float* cosT; const float* sinT; float scale;
};
struct Unit { int pm, pn, g; };

DI int lds_byte(int r, int c) { const int st = (r >> 4) * 2 + (c >> 5), rr = r & 15, cc = c & 31, ob = rr * 64 + cc * 2; return st * 1024 + (ob ^ (((ob >> 9) & 1) << 5)); }
DI void stage_rc(int b, int& R, int& C) { const int st = b / 1024, sb = b % 1024, swz = sb ^ (((sb >> 9) & 1) << 5); R = (st >> 1) * 16 + swz / 64; C = (st & 1) * 32 + (swz % 64) / 2; }
DI int perm32(int rho) { const int n = rho >> 4, i = rho & 15; return 8 * (i >> 2) + 4 * n + (i & 3); }

DI bool next_unit(const Ctx& cx, const GemmD& g, int i, Unit& u) {
    const int nM = g.M >> 8, nN = g.N >> 8, nwg1 = nM * nN, nwg = nwg1 * g.G;
    const int G_ = (int)gridDim.x; int vb = cx.bid - g.rot; if (vb < 0) vb += G_;
    const long L = (long)i * G_ + vb; if (L >= nwg) return false;
    int wgid = (int)L; { const int q = nwg / 8, r = nwg % 8, xcd = wgid % 8, off = wgid / 8; wgid = (xcd < r ? xcd * (q + 1) : r * (q + 1) + (xcd - r) * q) + off; }
    u.g = wgid / nwg1; wgid -= u.g * nwg1;
    const int nig = 8 * nN, gid = wgid / nig, fm = gid * 8, gsz = (nM - fm) < 8 ? (nM - fm) : 8;
    u.pm = fm + ((wgid % nig) % gsz); u.pn = (wgid % nig) / gsz; return true;
}

DI void gemm_epilogue(const GemmD& g, f32x4 (&acc)[2][2][4][2], const Unit& u, int wr, int wc, int fr_, int fq_, LAS unsigned char* lds) {
    int fr = fr_, fq = fq_; asm volatile("" : "+v"(fr), "+v"(fq));
    const int g1 = u.g >> g.gshift, g2 = u.g & ((1 << g.gshift) - 1);
    const int lrow0 = u.pm * BM + wr * 64 + fr;
    if (g.epi == EPI_RES) {
        float* C = (float*)g.C; const float* R = g.aux1 ? g.aux1 : (const float*)g.C;
        unsigned long long* xbuf = (unsigned long long*)g.aux0; unsigned* cnt = (unsigned*)((unsigned char*)g.aux0 + (MS_CNT - MS_SP)); bf16_t* XBo = (bf16_t*)((unsigned char*)g.aux0 + (WS_XB - WS_MISC - MS_SP));
        const unsigned want = (unsigned)g.opt;
        const int col0 = u.pn * BM + wc * 32 + 4 * fq;
        const int grow_t = g1 * g.growstep + u.pm * BM, panel = grow_t >> 8;
        const int wid = wr * 4 + wc, lane = fq * 16 + fr;
        LAS f32x2* P = (LAS f32x2*)(lds + 131072 + 64);
        LAS f32x2* S = (LAS f32x2*)(lds + 131072 + 64 + 8192);
#pragma unroll
        for (int ai = 0; ai < 2; ++ai)
#pragma unroll
            for (int m = 0; m < 4; ++m) {
                const int lr = ai * HALF + wr * 64 + m * 16 + fr; const float* rp = R + (size_t)(grow_t + lr) * g.ldc + col0;
                float sm = 0.f;
#pragma unroll
                for (int bj = 0; bj < 2; ++bj) {
#pragma unroll
                    for (int n = 0; n < 2; ++n) { const f32x4 x = *(const f32x4*)(rp + bj * HALF + n * 16); const f32x4 v = x * ALPHA_F + acc[ai][bj][m][n]; acc[ai][bj][m][n] = v; sm += (v[0] + v[1]) + (v[2] + v[3]); } }
                sm += __shfl_xor(sm, 16); sm += __shfl_xor(sm, 32);
                const float mw = sm * (1.0f / 64.0f); float q = 0.f;
#pragma unroll
                for (int bj = 0; bj < 2; ++bj)
#pragma unroll
                    for (int n = 0; n < 2; ++n) { const f32x4 dd = acc[ai][bj][m][n] - mw; q += (dd[0] * dd[0] + dd[1] * dd[1]) + (dd[2] * dd[2] + dd[3] * dd[3]); }
                q += __shfl_xor(q, 16); q += __shfl_xor(q, 32);
                if (fq == 0) P[lr * 4 + wc] = (f32x2){mw, q};
                if (m & 1) asm volatile("" ::: "memory");
            }
        asm volatile("s_waitcnt lgkmcnt(0)" ::: "memory"); __builtin_amdgcn_s_barrier(); asm volatile("" ::: "memory");
        const int prow = wid * 32 + (lane & 31);
        if (lane < 32) {
            const f32x2 a = P[prow * 4 + 0], b = P[prow * 4 + 1], c = P[prow * 4 + 2], d4 = P[prow * 4 + 3];
            const float mt = (a.x + b.x + c.x + d4.x) * 0.25f;
            const float da = a.x - mt, db = b.x - mt, dc = c.x - mt, dd = d4.x - mt;
            const float m2 = (a.y + b.y) + (c.y + d4.y) + 64.0f * ((da * da + db * db) + (dc * dc + dd * dd));
            __hip_atomic_store(xbuf + ((size_t)(grow_t + prow) * 4 + u.pn), ((unsigned long long)__float_as_uint(m2) << 32) | __float_as_uint(mt), __ATOMIC_RELAXED, __HIP_MEMORY_SCOPE_AGENT);
        }
        asm volatile("s_waitcnt vmcnt(0)" ::: "memory");
        if (lane == 0) __hip_atomic_fetch_add(cnt + 64 * panel, 1u, __ATOMIC_RELAXED, __HIP_MEMORY_SCOPE_AGENT);
        if (wid == 0) {
            unsigned spins = 0;
            while ((unsigned)__builtin_amdgcn_readfirstlane(__hip_atomic_load(cnt + 64 * panel, __ATOMIC_RELAXED, __HIP_MEMORY_SCOPE_AGENT)) < want) { __builtin_amdgcn_s_sleep(2); if (++spins > (1u << 22)) break; }
            __builtin_amdgcn_fence(__ATOMIC_ACQUIRE, "agent");
        }
        asm volatile("s_waitcnt vmcnt(0) lgkmcnt(0)" ::: "memory"); __builtin_amdgcn_s_barrier(); asm volatile("" ::: "memory");
        if (lane < 32) {
            const unsigned long long* slot = xbuf + (size_t)(grow_t + prow) * 4; float mt[4], m2[4]; float ms = 0.f;
#pragma unroll
            for (int t = 0; t < 4; ++t) { const unsigned long long w = __hip_atomic_load(slot + t, __ATOMIC_RELAXED, __HIP_MEMORY_SCOPE_AGENT); mt[t] = __uint_as_float((unsigned)w); m2[t] = __uint_as_float((unsigned)(w >> 32)); ms += mt[t]; }
            const float mean = ms * 0.25f; float q = 0.f;
#pragma unroll
            for (int t = 0; t < 4; ++t) { const float dm = mt[t] - mean; q += m2[t] + 256.0f * dm * dm; }
            S[prow] = (f32x2){mean, 1.0f / sqrtf(q * (1.0f / 1024.0f) + 1e-5f)};
        }
        asm volatile("s_waitcnt lgkmcnt(0)" ::: "memory"); __builtin_amdgcn_s_barrier(); asm volatile("" ::: "memory");
        const float* lg = g.cosT + col0; const float* lb = g.sinT + col0;
#pragma unroll
        for (int ai = 0; ai < 2; ++ai)
#pragma unroll
            for (int m = 0; m < 4; ++m) {
                const int lr = ai * HALF + wr * 64 + m * 16 + fr; const f32x2 sr = S[lr];
                float* cp = C + (size_t)(grow_t + lr) * g.ldc + col0; bf16_t* xp = XBo + (size_t)(grow_t + lr) * g.ldc + col0;
#pragma unroll
                for (int bj = 0; bj < 2; ++bj)
#pragma unroll
                    for (int n = 0; n < 2; ++n) {
                        const f32x4 gvv = *(const f32x4*)(lg + bj * HALF + n * 16), bvv = *(const f32x4*)(lb + bj * HALF + n * 16);
                        const f32x4 y = (acc[ai][bj][m][n] - sr.x) * sr.y * gvv + bvv;
                        *(f32x4*)(cp + bj * HALF + n * 16) = y;
                        u32x2 w; w.x = pk2(y[0], y[1]); w.y = pk2(y[2], y[3]); *(u32x2*)(xp + bj * HALF + n * 16) = w;
                    }
                asm volatile("" ::: "memory");
            }
        return;
    }
    if (g.epi == EPI_EXPN) {
        LAS float* X = (LAS float*)(lds + 131072 + 64);
        const float sc = g.scale * LOG2E;
#pragma unroll
        for (int ai = 0; ai < 2; ++ai)
#pragma unroll
            for (int m = 0; m < 4; ++m) {
                float rsum = 0.f;
#pragma unroll
                for (int bj = 0; bj < 2; ++bj)
#pragma unroll
                    for (int n = 0; n < 2; ++n) {
#pragma unroll
                        for (int j = 0; j < 4; ++j) { const float e = fexp2(fminf(acc[ai][bj][m][n][j] * sc - 5.77f, 15.9f)); rsum += e; } }
                rsum += __shfl_xor(rsum, 16); rsum += __shfl_xor(rsum, 32);
                if (fq == 0) X[(ai * HALF + wr * 64 + m * 16 + fr) * 4 + wc] = rsum;
                __builtin_amdgcn_sched_barrier(0);
            }
        asm volatile("s_waitcnt lgkmcnt(0)" ::: "memory"); __builtin_amdgcn_s_barrier(); asm volatile("" ::: "memory");
    }
    if (g.epi == EPI_GLU) {
        bf16_t* ACT = (bf16_t*)g.C; bf16_t* HF = (bf16_t*)g.cosT; bf16_t* HL = (bf16_t*)g.sinT;
        const float* cw = g.aux0; const float* cb = g.aux1;
        const int ch0 = u.pn * 128 + wc * 32 + 8 * fq;
        f32x4 wg[2][3], wu[2][3], bgv[2], buv[2];
#pragma unroll
        for (int n = 0; n < 2; ++n) {
#pragma unroll
            for (int k = 0; k < 3; ++k) { wg[n][k] = *(const f32x4*)(cw + k * 5632 + ch0 + 4 * n); wu[n][k] = *(const f32x4*)(cw + k * 5632 + 2816 + ch0 + 4 * n); }
            bgv[n] = *(const f32x4*)(cb + ch0 + 4 * n); buv[n] = *(const f32x4*)(cb + 2816 + ch0 + 4 * n);
        }
#pragma unroll
        for (int ai = 0; ai < 2; ++ai) {
            const int rbase = u.pm * BM + ai * HALF + wr * 64, blk = rbase >> 6;
#pragma unroll
            for (int m = 0; m < 4; ++m) {
                const int row = rbase + 16 * m + fr;
                f32x4 o[2];
#pragma unroll
                for (int n = 0; n < 2; ++n) {
                    const f32x4 G = acc[ai][0][m][n], U = acc[ai][1][m][n];
                    f32x4 Gp = {0.f, 0.f, 0.f, 0.f}, Up = Gp;
                    if (m > 0) { Gp = acc[ai][0][m > 0 ? m - 1 : 0][n]; Up = acc[ai][1][m > 0 ? m - 1 : 0][n]; }
                    f32x4 g1, g2, u1, u2;
#pragma unroll
                    for (int j = 0; j < 4; ++j) {
                        const int gi = __float_as_int(G[j]), gpi = __float_as_int(Gp[j]), ui = __float_as_int(U[j]), upi = __float_as_int(Up[j]);
                        g1[j] = __int_as_float(__builtin_amdgcn_update_dpp(__builtin_amdgcn_update_dpp(0, gpi, 0x121, 0xf, 0xf, false), gi, 0x111, 0xf, 0xf, false));
                        g2[j] = __int_as_float(__builtin_amdgcn_update_dpp(__builtin_amdgcn_update_dpp(0, gpi, 0x122, 0xf, 0xf, false), gi, 0x112, 0xf, 0xf, false));
                        u1[j] = __int_as_float(__builtin_amdgcn_update_dpp(__builtin_amdgcn_update_dpp(0, upi, 0x121, 0xf, 0xf, false), ui, 0x111, 0xf, 0xf, false));
                        u2[j] = __int_as_float(__builtin_amdgcn_update_dpp(__builtin_amdgcn_update_dpp(0, upi, 0x122, 0xf, 0xf, false), ui, 0x112, 0xf, 0xf, false));
                    }
                    const f32x4 gv = bgv[n] + wg[n][0] * g2 + wg[n][1] * g1 + wg[n][2] * G;
                    const f32x4 uv = buv[n] + wu[n][0] * u2 + wu[n][1] * u1 + wu[n][2] * U;
#pragma unroll
                    for (int j = 0; j < 4; ++j) o[n][j] = gv[j] * __builtin_amdgcn_rcpf(1.f + fexp(-gv[j])) * uv[j];
                }
                u32x4 w; w.x = pk2(o[0][0], o[0][1]); w.y = pk2(o[0][2], o[0][3]); w.z = pk2(o[1][0], o[1][1]); w.w = pk2(o[1][2], o[1][3]);
                *(u32x4*)(ACT + (size_t)row * 2816 + ch0) = w;
                if ((m == 0 && fr < 2) || (m == 3 && fr >= 14)) {
                    bf16_t* dst = (m == 0 ? HF + (size_t)(blk * 2 + fr) * 5632 : HL + (size_t)(blk * 2 + fr - 14) * 5632) + ch0;
                    const f32x4 G0 = acc[ai][0][m][0], G1 = acc[ai][0][m][1], U0 = acc[ai][1][m][0], U1 = acc[ai][1][m][1];
                    u32x4 wgp, wup; wgp.x = pk2(G0[0], G0[1]); wgp.y = pk2(G0[2], G0[3]); wgp.z = pk2(G1[0], G1[1]); wgp.w = pk2(G1[2], G1[3]);
                    wup.x = pk2(U0[0], U0[1]); wup.y = pk2(U0[2], U0[3]); wup.z = pk2(U1[0], U1[1]); wup.w = pk2(U1[2], U1[3]);
                    *(u32x4*)dst = wgp; *(u32x4*)(dst + 2816) = wup;
                }
            }
        }
        return;
    }
    bf16_t* C = (bf16_t*)g.C + (g1 * g.sC1 + g2 * g.sC2);
    const int grow0 = g1 * g.growstep + lrow0;
    const int col0 = u.pn * BM + wc * 32 + 8 * fq;
#pragma unroll
    for (int ai = 0; ai < 2; ++ai)
#pragma unroll
        for (int m = 0; m < 4; ++m) {
            const int lrow = lrow0 + ai * HALF + m * 16, grow = grow0 + ai * HALF + m * 16;
            bf16_t* rowp = C + (size_t)lrow * g.ldc + col0;
            float rs = 1.f;
            if (g.epi == EPI_BF16) { if (g.aux0) rs = g.aux0[grow]; }
            else if (g.epi == EPI_EXPN) { const f32x4 x4 = *(const LAS f32x4*)((LAS float*)(lds + 131072 + 64) + (ai * HALF + wr * 64 + m * 16 + fr) * 4); rs = __builtin_amdgcn_rcpf((x4.x + x4.y) + (x4.z + x4.w)); }
#pragma unroll
            for (int bj = 0; bj < 2; ++bj) {
                f32x4 v0 = acc[ai][bj][m][0], v1 = acc[ai][bj][m][1];
                const int col = col0 + bj * HALF;
                if (g.epi == EPI_EXPN) {
                    const float sc = g.scale * LOG2E;
#pragma unroll
                    for (int j = 0; j < 4; ++j) { v0[j] = fexp2(fminf(v0[j] * sc - 5.77f, 15.9f)) * rs; v1[j] = fexp2(fminf(v1[j] * sc - 5.77f, 15.9f)) * rs; }
                } else if (g.epi == EPI_BF16) {
                    v0 *= rs; v1 *= rs;
                    bool dorope = false; int f0 = 0;
                    if (g.opt == ROPE_SWA) { dorope = col < 1280; f0 = (col & 63) >> 1; }
                    else if (g.opt == ROPE_MLAQ) { const int hc = col % 192; dorope = hc >= 128; f0 = (hc - 128) >> 1; }
                    if (dorope) {
                        const int pos = grow & (SEQ - 1);
                        const f32x4 cs = *(const f32x4*)(g.cosT + pos * 32 + f0), sn = *(const f32x4*)(g.sinT + pos * 32 + f0);
                        f32x4 r0, r1;
                        r0.x = v0.x * cs.x - v0.y * sn.x; r0.y = v0.y * cs.x + v0.x * sn.x;
                        r0.z = v0.z * cs.y - v0.w * sn.y; r0.w = v0.w * cs.y + v0.z * sn.y;
                        r1.x = v1.x * cs.z - v1.y * sn.z; r1.y = v1.y * cs.z + v1.x * sn.z;
                        r1.z = v1.z * cs.w - v1.w * sn.w; r1.w = v1.w * cs.w + v1.z * sn.w;
                        v0 = r0; v1 = r1;
                    }
                } else if (g.epi == EPI_SIG) {
                    const float* bp = (col < 256) ? (g.aux0 + g2 * 256 + col) : (g.aux1 + g2 * 256 + col - 256);
                    const f32x4 b0 = *(const f32x4*)bp, b1 = *(const f32x4*)(bp + 4);
                    v0 += b0; v1 += b1;
#pragma unroll
                    for (int j = 0; j < 4; ++j) { v0[j] = 1.0f / (1.0f + fexp(-v0[j])); v1[j] = 1.0f / (1.0f + fexp(-v1[j])); }
                }
                u32x4 w; w.x = pk2(v0[0], v0[1]); w.y = pk2(v0[2], v0[3]); w.z = pk2(v1[0], v1[1]); w.w = pk2(v1[2], v1[3]);
                *(u32x4*)(rowp + bj * HALF) = w;
            }
        }
}

DI void gemm_phase(const Ctx& cx, LAS unsigned char* lds, const GemmD& g) {
    const int tid = cx.tid, wid = __builtin_amdgcn_readfirstlane(tid >> 6), lane = tid & 63, wr = wid >> 2, wc = wid & 3, fr = lane & 15, fq = lane >> 4;
    const int K = g.K, nt = K / BK;
    const bool PERM = (g.epi != EPI_RES);
    unsigned voffA[2], voffB[2];
#pragma unroll
    for (int i = 0; i < 2; ++i) { int R, C; stage_rc(tid * 16 + i * 8192, R, C); const int Rb = PERM ? ((R & ~31) + perm32(R & 31)) : R;
        voffA[i] = (unsigned)(R * g.lda + C) * 2u; voffB[i] = (unsigned)(Rb * g.ldb + C) * 2u; }
    const size_t kstep = (size_t)(BK * 2);
    const size_t hstepA = (size_t)HALF * g.lda * 2, hstepB = (size_t)HALF * g.ldb * 2;
    const unsigned ldsw = (unsigned)wid * 1024u;
    const int aoff = lds_byte(wr * 64 + fr, fq * 8), boff = lds_byte(wc * 32 + fr, fq * 8);
#define PG8_SA(b, h) (((b) * 2 + (h)) * HTB)
#define PG8_SB(b, h) ((4 + (b) * 2 + (h)) * HTB)
#define PG8_STAGE(bufoff, gbase, voff) do { _Pragma("unroll") for (int _i = 0; _i < 2; ++_i) \
        __builtin_amdgcn_global_load_lds((const unsigned*)((const char*)(gbase) + (voff)[_i]), (LAS unsigned*)(lds + (bufoff) + ldsw + _i * 8192), 16, 0, 0); } while (0)
#define PG8_LDA(dst, b, h) do { _Pragma("unroll") for (int m = 0; m < 4; ++m) _Pragma("unroll") for (int k = 0; k < 2; ++k) dst[m][k] = *(const LAS bf16x8*)(lds + PG8_SA(b, h) + aoff + m * 2048 + k * 1024); } while (0)
#define PG8_LDB(dst, b, h) do { _Pragma("unroll") for (int n = 0; n < 2; ++n) _Pragma("unroll") for (int k = 0; k < 2; ++k) dst[n][k] = *(const LAS bf16x8*)(lds + PG8_SB(b, h) + boff + n * 2048 + k * 1024); } while (0)
#define PG8_MMA(ai, bj, At, Bt) do { __builtin_amdgcn_s_setprio(1); _Pragma("unroll") for (int m = 0; m < 4; ++m) _Pragma("unroll") for (int n = 0; n < 2; ++n) _Pragma("unroll") for (int k = 0; k < 2; ++k) \
        acc[ai][bj][m][n] = __builtin_amdgcn_mfma_f32_16x16x32_f16(__builtin_bit_cast(h16x8, Bt[n][k]), __builtin_bit_cast(h16x8, At[m][k]), acc[ai][bj][m][n], 0, 0, 0); __builtin_amdgcn_s_setprio(0); } while (0)
#define PG8_WAIT_V(n) asm volatile("s_waitcnt vmcnt(" #n ")" ::: "memory")
#define PG8_WAIT_L(n) asm volatile("s_waitcnt lgkmcnt(" #n ")" ::: "memory")
#define PG8_BAR __builtin_amdgcn_s_barrier()
#define PG8_SCHED __builtin_amdgcn_sched_barrier(0)
    Unit cur, nxt; int ui = 0;
    if (!next_unit(cx, g, 0, cur)) return;
    f32x4 acc[2][2][4][2];
#pragma unroll
    for (int a = 0; a < 2; ++a)
#pragma unroll
        for (int b = 0; b < 2; ++b)
#pragma unroll
            for (int m = 0; m < 4; ++m)
#pragma unroll
                for (int n = 0; n < 2; ++n) acc[a][b][m][n] = (f32x4){0.f, 0.f, 0.f, 0.f};
    bf16x8 At[4][2], B0[2][2], B1[2][2];
    const char* cA = (const char*)g.A + 2 * ((cur.g >> g.gshift) * g.sA1 + (cur.g & ((1 << g.gshift) - 1)) * g.sA2 + (long)cur.pm * BM * g.lda);
    const char* cB = (const char*)g.Bt + 2 * ((cur.g >> g.gshift) * g.sB1 + (cur.g & ((1 << g.gshift) - 1)) * g.sB2 + (long)cur.pn * BM * g.ldb);
    PG8_STAGE(PG8_SB(0, 0), cB, voffB); PG8_STAGE(PG8_SB(0, 1), cB + hstepB, voffB); PG8_STAGE(PG8_SA(0, 0), cA, voffA); PG8_STAGE(PG8_SA(0, 1), cA + hstepA, voffA);
    if (wr == 1) PG8_BAR;
    PG8_WAIT_V(2); PG8_BAR;
    PG8_STAGE(PG8_SB(1, 0), cB + kstep, voffB); PG8_STAGE(PG8_SA(1, 0), cA + kstep, voffA); PG8_STAGE(PG8_SB(1, 1), cB + hstepB + kstep, voffB);
    PG8_WAIT_V(6); PG8_BAR;
    for (;;) {
        const bool has_next = next_unit(cx, g, ui + 1, nxt);
        const char* nA = has_next ? (const char*)g.A + 2 * ((nxt.g >> g.gshift) * g.sA1 + (nxt.g & ((1 << g.gshift) - 1)) * g.sA2 + (long)nxt.pm * BM * g.lda) : cA;
        const char* nB = has_next ? (const char*)g.Bt + 2 * ((nxt.g >> g.gshift) * g.sB1 + (nxt.g & ((1 << g.gshift) - 1)) * g.sB2 + (long)nxt.pn * BM * g.ldb) : cB;
        for (int t = 0; t < nt; t += 2) {
            const bool last = (t == nt - 2);
            const char* a1 = cA + (size_t)(t + 1) * kstep;
            const char* a2 = last ? nA : cA + (size_t)(t + 2) * kstep; const char* b2 = last ? nB : cB + (size_t)(t + 2) * kstep;
            const char* a3 = a2 + kstep; const char* b3 = b2 + kstep;
            PG8_LDB(B0, 0, 0); PG8_LDB(B1, 0, 1); PG8_SCHED; PG8_LDA(At, 0, 0); PG8_STAGE(PG8_SA(1, 1), a1 + hstepA, voffA);
            PG8_WAIT_V(8); PG8_WAIT_L(0); PG8_BAR; PG8_MMA(0, 0, At, B0); PG8_MMA(0, 1, At, B1); PG8_BAR; PG8_SCHED;
            PG8_LDA(At, 0, 1); PG8_STAGE(PG8_SB(0, 0), b2, voffB); PG8_STAGE(PG8_SB(0, 1), b2 + hstepB, voffB); PG8_STAGE(PG8_SA(0, 0), a2, voffA);
            PG8_WAIT_V(8); PG8_WAIT_L(0); PG8_BAR; PG8_MMA(1, 0, At, B0); PG8_MMA(1, 1, At, B1); PG8_BAR; PG8_SCHED;
            PG8_LDB(B0, 1, 0); PG8_LDB(B1, 1, 1); PG8_SCHED; PG8_LDA(At, 1, 0); PG8_STAGE(PG8_SA(0, 1), a2 + hstepA, voffA);
            PG8_WAIT_V(8); PG8_WAIT_L(0); PG8_BAR; PG8_MMA(0, 0, At, B0); PG8_MMA(0, 1, At, B1); PG8_BAR; PG8_SCHED;
            PG8_LDA(At, 1, 1); PG8_STAGE(PG8_SB(1, 0), b3, voffB); PG8_STAGE(PG8_SB(1, 1), b3 + hstepB, voffB); PG8_STAGE(PG8_SA(1, 0), a3, voffA);
            PG8_WAIT_V(8); PG8_WAIT_L(0); PG8_BAR; PG8_MMA(1, 0, At, B0); PG8_MMA(1, 1, At, B1); PG8_BAR; PG8_SCHED;
        }
        if (wr == 0) PG8_BAR;
        gemm_epilogue(g, acc, cur, wr, wc, fr, fq, lds);
        if (!has_next) break;
#pragma unroll
        for (int a = 0; a < 2; ++a)
#pragma unroll
            for (int b = 0; b < 2; ++b)
#pragma unroll
                for (int m = 0; m < 4; ++m)
#pragma unroll
                    for (int n = 0; n < 2; ++n) acc[a][b][m][n] = (f32x4){0.f, 0.f, 0.f, 0.f};
        cur = nxt; cA = nA; cB = nB; ++ui;
        if (wr == 1) PG8_BAR;
    }
    PG8_WAIT_V(0);
    PG8_BAR;
#undef PG8_SA
#undef PG8_SB
#undef PG8_STAGE
#undef PG8_LDA
#undef PG8_LDB
#undef PG8_MMA
#undef PG8_WAIT_V
#undef PG8_WAIT_L
#undef PG8_BAR
#undef PG8_SCHED
}

#define MFMA32(a, b, c) __builtin_amdgcn_mfma_f32_32x32x16_f16(__builtin_bit_cast(h16x8, (a)), __builtin_bit_cast(h16x8, (b)), (c), 0, 0, 0)
template <int DN, int DR, int DV, bool RES = false>
DI void attn_block(const Ctx& cx, LAS unsigned char* lds, const bf16_t* Qw, int ldq, const bf16_t* Kb, int ldk, const bf16_t* Krb, int ldkr,
                   const bf16_t* Vb, int ldv, int k_begin, int k_end, int qpos0, int window, float scale2, float m0, float l0, bf16_t* Ow, int ldo) {
    constexpr int DQK = DN + DR, KS = DQK / 16, KSTR = (DQK + 8) * 2, VSTR = (DV == 128 ? 320 : 192), KBYTES = 64 * KSTR, VBYTES = 64 * VSTR, NDT = DV / 32;
    const int tid = cx.tid, lane = tid & 63, h = lane >> 5, c = lane & 31;
    const bool late = __builtin_amdgcn_readfirstlane(tid >> 6) >= 4;
    bf16x8 q[KS];
#pragma unroll
    for (int kk = 0; kk < KS; ++kk) q[kk] = *(const bf16x8*)(Qw + (size_t)c * ldq + 16 * kk + 8 * h);
    f32x16 o[NDT];
#pragma unroll
    for (int dt = 0; dt < NDT; ++dt)
#pragma unroll
        for (int j = 0; j < 16; ++j) o[dt][j] = 0.f;
    float m = m0, l = (h == 0) ? l0 : 0.f;
    constexpr int NCH = DN / 8, NKN = DN / 64, KPI = 512 / NCH;
    constexpr int VCH = DV / 8, NVL = DV / 64, VPI = 512 / VCH;
    u32x4 kreg[NKN], vreg[NVL], rreg;
    const unsigned kgo = (unsigned)(((tid / NCH) * ldk + (tid % NCH) * 8) * 2), klo = (unsigned)((tid / NCH) * KSTR + (tid % NCH) * 16);
    const unsigned vgo = (unsigned)(((tid / VCH) * ldv + (tid % VCH) * 8) * 2), vlo = (unsigned)((tid / VCH) * VSTR + (tid % VCH) * 16);
    const unsigned vrd = (unsigned)((4 * h + ((lane & 15) >> 2)) * VSTR + (16 * ((lane >> 4) & 1) + 4 * (lane & 3)) * 2);
    const unsigned rgo = (unsigned)(((tid >> 3) * ldkr + (tid & 7) * 8) * 2), rlo = (unsigned)((tid >> 3) * KSTR + DN * 2 + (tid & 7) * 16);
    const int ntiles = (k_end - k_begin) >> 6;
#define ATT_GLOAD(k0_) do { const char* kb_ = (const char*)(Kb + (size_t)(k0_) * ldk); const char* vb_ = (const char*)(Vb + (size_t)(k0_) * ldv); \
        _Pragma("unroll") for (int i = 0; i < NKN; ++i) kreg[i] = *(const u32x4*)(kb_ + (size_t)i * KPI * ldk * 2 + kgo); \
        _Pragma("unroll") for (int i = 0; i < NVL; ++i) vreg[i] = *(const u32x4*)(vb_ + (size_t)i * VPI * ldv * 2 + vgo); \
        if (DR > 0) rreg = *(const u32x4*)((const char*)(Krb + (size_t)(k0_) * ldkr) + rgo); } while (0)
#define ATT_LSTORE(kb_, vb_) do { LAS unsigned char* Kt_ = lds + (kb_) * KBYTES; LAS unsigned char* Vt_ = lds + VBASE + (vb_) * VBYTES; \
        _Pragma("unroll") for (int i = 0; i < NKN; ++i) *(LAS u32x4*)(Kt_ + i * KPI * KSTR + klo) = kreg[i]; \
        if (DR > 0) *(LAS u32x4*)(Kt_ + rlo) = rreg; \
        _Pragma("unroll") for (int i = 0; i < NVL; ++i) *(LAS u32x4*)(Vt_ + i * VPI * VSTR + vlo) = vreg[i]; } while (0)
    u32x4 pw[4];
    float alpha = 1.f; bool pend = false;
#define ATT_PV(vb_) do { const LAS unsigned char* Vt = lds + VBASE + (vb_) * VBYTES; \
        _Pragma("unroll") for (int dt = 0; dt < NDT; ++dt) _Pragma("unroll") for (int j = 0; j < 16; ++j) o[dt][j] *= alpha; \
        _Pragma("unroll") for (int ss = 0; ss < 4; ++ss) { const bf16x8 pf = __builtin_bit_cast(bf16x8, pw[ss]); \
            _Pragma("unroll") for (int dt = 0; dt < NDT; ++dt) { \
                LAS unsigned char* vp = (LAS unsigned char*)Vt + vrd + ((ss >> 1) * 32 + 16 * (ss & 1)) * VSTR + dt * 64; \
                const s16x4 lo = __builtin_amdgcn_ds_read_tr16_b64_v4i16((LAS s16x4*)vp), hi = __builtin_amdgcn_ds_read_tr16_b64_v4i16((LAS s16x4*)(vp + 8 * VSTR)); \
                bf16x8 vw; vw[0] = lo[0]; vw[1] = lo[1]; vw[2] = lo[2]; vw[3] = lo[3]; vw[4] = hi[0]; vw[5] = hi[1]; vw[6] = hi[2]; vw[7] = hi[3]; \
                o[dt] = MFMA32(vw, pf, o[dt]); } \
            __builtin_amdgcn_sched_barrier(0); } } while (0)
    constexpr int VBASE = RES ? 4 * KBYTES : 2 * KBYTES;
    if (!RES) { ATT_GLOAD(k_begin); ATT_LSTORE(0, 0); __syncthreads(); }
    int vcur = 0, vprev = 2;
    for (int t = 0; t <= ntiles; ++t) {
        const int k0 = k_begin + 64 * t;
        if (!RES && t + 1 < ntiles) ATT_GLOAD(k0 + 64);
        if (late && pend) { ATT_PV(vprev); pend = false; }
        const bool vis = (t < ntiles) && (k0 <= qpos0 + 31) && (qpos0 - (k0 + 63) < window);
        if (vis) {
            const LAS unsigned char* Kt = lds + (RES ? t : (t & 1)) * KBYTES;
            f32x16 s0, s1;
#pragma unroll
            for (int j = 0; j < 16; ++j) { s0[j] = 0.f; s1[j] = 0.f; }
#pragma unroll
            for (int kk = 0; kk < KS; ++kk) {
                const bf16x8 a0 = *(const LAS bf16x8*)(Kt + c * KSTR + (16 * kk + 8 * h) * 2);
                const bf16x8 a1 = *(const LAS bf16x8*)(Kt + (32 + c) * KSTR + (16 * kk + 8 * h) * 2);
                s0 = MFMA32(a0, q[kk], s0); s1 = MFMA32(a1, q[kk], s1);
                if (kk & 1) __builtin_amdgcn_sched_barrier(0);
            }
            const bool full = (k0 + 63 <= qpos0) && (qpos0 + 31 - k0 < window);
            if (!full) {
                const int dbase = qpos0 + c - k0 - 4 * h;
#pragma unroll
                for (int j = 0; j < 16; ++j) { const int d0 = dbase - (8 * (j >> 2) + (j & 3)), d1 = d0 - 32;
                    if (d0 < 0 || d0 >= window) s0[j] = -INFINITY;
                    if (d1 < 0 || d1 >= window) s1[j] = -INFINITY; }
            }
            float tmax = fmaxf(s0[0], s1[0]);
#pragma unroll
            for (int j = 1; j < 16; ++j) tmax = fmaxf(tmax, fmaxf(s0[j], s1[j]));
            tmax = fmaxf(tmax, __shfl_xor(tmax, 32)) * scale2;
            const float mn = fmaxf(m, tmax); alpha = fexp2(m - mn); m = mn;
            float psum = 0.f;
#pragma unroll
            for (int j = 0; j < 16; ++j) { s0[j] = fexp2(__builtin_fmaf(s0[j], scale2, -mn)); s1[j] = fexp2(__builtin_fmaf(s1[j], scale2, -mn)); psum += s0[j] + s1[j]; }
            l = l * alpha + psum;
#pragma unroll
            for (int s = 0; s < 2; ++s) {
                pw[s].x = pk2(s0[8 * s + 0], s0[8 * s + 1]); pw[s].y = pk2(s0[8 * s + 2], s0[8 * s + 3]); pw[s].z = pk2(s0[8 * s + 4], s0[8 * s + 5]); pw[s].w = pk2(s0[8 * s + 6], s0[8 * s + 7]);
                pw[2 + s].x = pk2(s1[8 * s + 0], s1[8 * s + 1]); pw[2 + s].y = pk2(s1[8 * s + 2], s1[8 * s + 3]); pw[2 + s].z = pk2(s1[8 * s + 4], s1[8 * s + 5]); pw[2 + s].w = pk2(s1[8 * s + 6], s1[8 * s + 7]);
            }
            if (late) pend = true; else ATT_PV(vcur);
        }
        const int vnext = RES ? vcur + 1 : ((vcur == 2) ? 0 : vcur + 1);
        if (!RES && t + 1 < ntiles) ATT_LSTORE((t + 1) & 1, vnext);
        vprev = vcur; vcur = vnext;
        if (!RES) __syncthreads();
    }
    l += __shfl_xor(l, 32);
    const float inv = 1.0f / l;
#pragma unroll
    for (int dt = 0; dt < NDT; ++dt)
#pragma unroll
        for (int jq = 0; jq < 4; ++jq) {
            u32x2 w; w.x = pk2(o[dt][4 * jq] * inv, o[dt][4 * jq + 1] * inv); w.y = pk2(o[dt][4 * jq + 2] * inv, o[dt][4 * jq + 3] * inv);
            *(u32x2*)(Ow + (size_t)c * ldo + dt * 32 + 8 * jq + 4 * h) = w;
        }
#undef ATT_GLOAD
#undef ATT_LSTORE
#undef ATT_PV
}

DI int srccol(int mode, int n) {
    if (mode == 1) return n < 1280 ? ((n & ~63) + ((n & 63) >> 1) + 32 * (n & 1)) : n;
    if (mode == 2) { const int hh = n / 192, j = n % 192; if (j < 128) return n; const int jj = j - 128; return hh * 192 + 128 + (jj >> 1) + 32 * (jj & 1); }
    if (mode == 4) { const int ch = (n >> 8) * 128 + (n & 127); return ((n >> 7) & 1) ? 2816 + ch : ch; }
    if (mode == 3) { if (n < 640) return n; if (n < 704) { const int jj = n - 640; return 640 + (jj >> 1) + 32 * (jj & 1); } return -1; }
    return n;
}
DI void transpose_item(const float* src, int ldsrc, int K, int Nd, int mode, const float* gain, bf16_t* dst, LAS float* scr, int item, int lane) {
    const int nblk = Nd / 32, kb = item / nblk, nb = item % nblk, k0 = 64 * kb, n0 = 32 * nb;
    const int sc0 = srccol(mode, n0 + (lane & 31));
    const int sc = sc0 < 0 ? 0 : sc0; const float msk = sc0 < 0 ? 0.f : 1.f;
    if (mode == 0 || mode == 4) {
        const int scb = srccol(mode, n0) + (lane & 7) * 4;
#pragma unroll
        for (int i = 0; i < 8; ++i) { const int kk = (lane >> 3) + 8 * i; const f32x4 v = *(const f32x4*)(src + (size_t)(k0 + kk) * ldsrc + scb);
            LAS float* d = scr + kk * 33 + (lane & 7) * 4; d[0] = v.x; d[1] = v.y; d[2] = v.z; d[3] = v.w; }
    } else {
#pragma unroll 8
        for (int i = 0; i < 32; ++i) { const int kk = 2 * i + (lane >> 5); scr[kk * 33 + (lane & 31)] = src[(size_t)(k0 + kk) * ldsrc + sc] * msk; }
    }
    LDS_WAIT();
    const int c = lane & 7;
    f32x4 ga = {1.f, 1.f, 1.f, 1.f}, gb = ga;
    if (gain) { ga = *(const f32x4*)(gain + k0 + 8 * c); gb = *(const f32x4*)(gain + k0 + 8 * c + 4); }
#pragma unroll
    for (int j = 0; j < 4; ++j) { const int n = (lane >> 3) + 8 * j; const LAS float* s = scr + (8 * c) * 33 + n;
        u32x4 o; o.x = pk2(s[0 * 33] * ga.x, s[1 * 33] * ga.y); o.y = pk2(s[2 * 33] * ga.z, s[3 * 33] * ga.w); o.z = pk2(s[4 * 33] * gb.x, s[5 * 33] * gb.y); o.w = pk2(s[6 * 33] * gb.z, s[7 * 33] * gb.w);
        *(u32x4*)(dst + (size_t)(n0 + n) * K + k0 + 8 * c) = o; }
    LDS_WAIT();
}
DI void cvt_mat(int gw, int NGW, int lane, LAS float* scr, int& base, const float* src, int ldsrc, int K, int Nd, int mode, const float* gain, bf16_t* dst) {
    const int nitems = (K / 64) * (Nd / 32);
    for (int it = (gw + NGW - (base % NGW)) % NGW; it < nitems; it += NGW) transpose_item(src, ldsrc, K, Nd, mode, gain, dst, scr, it, lane);
    base += nitems;
}
DI void convert_set(const Ctx& cx, const Params& p, int set, LAS unsigned char* lds, int part) {
    const int wid = __builtin_amdgcn_readfirstlane(cx.tid >> 6), lane = cx.tid & 63;
    LAS float* scr = (LAS float*)(lds + wid * 8704);
    const int gw = cx.bid * 8 + wid, NGW = gridDim.x * 8;
    bf16_t* WB = (bf16_t*)(p.ws + WS_WB);
    int base = 0;
    if (set == 9) { cvt_mat(gw, NGW, lane, scr, base, p.in[20], 2048, 1024, 2048, 0, nullptr, (bf16_t*)(p.ws + WS_T)); return; }
    if (part == 1 && set >= 2) cvt_mat(gw, NGW, lane, scr, base, p.in[26] + (size_t)(set - 1) * 2816 * 1024, 1024, 2816, 1024, 0, nullptr, WB + OFF_FD);
    if (set >= 4) return;
    const int L = set, kind = L % 3, mj = L / 3;
    {
    { const f32x4* src4 = (const f32x4*)(p.in[21] + (size_t)L * 1048576); u32x2* dst2 = (u32x2*)(WB + OFF_XQ);
      for (int idx = cx.bid * 512 + cx.tid; idx < 262144; idx += gridDim.x * 512) { const f32x4 v = src4[idx]; u32x2 w; w.x = pk2(v.x, v.y); w.y = pk2(v.z, v.w); dst2[idx] = w; } }
    cvt_mat(gw, NGW, lane, scr, base, p.in[22] + (size_t)L * 1048576, 1024, 1024, 1024, 0, nullptr, WB + OFF_XO);
    cvt_mat(gw, NGW, lane, scr, base, p.in[23] + (size_t)L * 1024 * 5632, 5632, 1024, 5632, 4, nullptr, WB + OFF_FU);
    }
    if (part == 0) cvt_mat(gw, NGW, lane, scr, base, p.in[26] + (size_t)L * 2816 * 1024, 1024, 2816, 1024, 0, nullptr, WB + OFF_FD);
    if (kind == 0) {
        cvt_mat(gw, NGW, lane, scr, base, p.in[4] + (size_t)mj * 1048576, 1024, 1024, 1024, 0, nullptr, WB + OFF_MO);
        cvt_mat(gw, NGW, lane, scr, base, p.in[2] + (size_t)mj * 1024 * 1536, 1536, 1024, 1536, 1, nullptr, WB + OFF_M1);
    } else if (kind == 1) {
        cvt_mat(gw, NGW, lane, scr, base, p.in[13], 1024, 1024, 1024, 0, nullptr, WB + OFF_MO);
        cvt_mat(gw, NGW, lane, scr, base, p.in[5], 2048, 1024, 2048, 0, nullptr, WB + OFF_M1);
#pragma unroll 1
        for (int hh = 0; hh < 4; ++hh) {
            cvt_mat(gw, NGW, lane, scr, base, p.in[8] + (size_t)hh * 65536, 256, 256, 256, 0, nullptr, WB + OFF_M2 + (size_t)(hh * 512) * 256);
            cvt_mat(gw, NGW, lane, scr, base, p.in[10] + (size_t)hh * 65536, 256, 256, 256, 0, nullptr, WB + OFF_M2 + (size_t)(hh * 512 + 256) * 256);
        }
    } else {
        cvt_mat(gw, NGW, lane, scr, base, p.in[19], 1024, 1024, 1024, 0, nullptr, WB + OFF_MO);
        cvt_mat(gw, NGW, lane, scr, base, p.in[14], 704, 1024, 768, 3, nullptr, WB + OFF_M1);
        cvt_mat(gw, NGW, lane, scr, base, p.in[17], 1536, 384, 1536, 2, p.in[15], WB + OFF_M2);
        cvt_mat(gw, NGW, lane, scr, base, p.in[18], 2048, 256, 2048, 0, p.in[16], WB + OFF_M3);
    }
}

DI void setup_phase(const Ctx& cx, const Params& p, LAS unsigned char* lds) {
    const size_t gt = (size_t)cx.bid * 512 + cx.tid, NT = (size_t)gridDim.x * 512;
    float* cosT = (float*)(p.ws + WS_MISC + MS_COS); float* sinT = (float*)(p.ws + WS_MISC + MS_SIN);
    for (size_t idx = gt; idx < (size_t)SEQ * 32; idx += NT) {
        const int pos = (int)(idx >> 5), i = (int)(idx & 31);
        double r = 1.0; for (int k = 0; k < i; ++k) r *= 0.7498942093324559;
        const float inv = (float)r; const float ang = (float)pos * inv;
        const double a = (double)ang * 0.15915494309189535; const double fr = a - __builtin_rint(a);
        const float f = (float)fr;
        cosT[idx] = __builtin_amdgcn_cosf(f); sinT[idx] = __builtin_amdgcn_sinf(f);
    }
    const f32x4* x4 = (const f32x4*)p.in[0]; u32x2* xb = (u32x2*)(p.ws + WS_XB);
    for (size_t idx = gt; idx < (size_t)MTOK * 256; idx += NT) { const f32x4 v = x4[idx]; u32x2 w; w.x = pk2(v.x, v.y); w.y = pk2(v.z, v.w); xb[idx] = w; }
    const f32x4* m4 = (const f32x4*)p.in[1]; u32x2* mb = (u32x2*)(p.ws + WS_MISC + MS_MEMB);
    for (size_t idx = gt; idx < (size_t)1024 * 256; idx += NT) { const f32x4 v = m4[idx]; u32x2 w; w.x = pk2(v.x, v.y); w.y = pk2(v.z, v.w); mb[idx] = w; }
    convert_set(cx, p, 9, lds, 0);
    convert_set(cx, p, 0, lds, 0);
}

DI void ln_phase(const Ctx& cx, const Params& p, int lnidx) {
    const float* g = p.in[27] + lnidx * 1024; const float* b = p.in[28] + lnidx * 1024;
    float* X = p.out; bf16_t* XB = (bf16_t*)(p.ws + WS_XB); f32x2* ST = (f32x2*)(p.ws + WS_MISC + MS_SP);
    const bool final_ln = (lnidx == 11);
    const int wid = __builtin_amdgcn_readfirstlane(cx.tid >> 6), lane = cx.tid & 63, gw = cx.bid * 8 + wid, NGW = gridDim.x * 8;
    f32x4 gv[4], bv[4];
#pragma unroll
    for (int j = 0; j < 4; ++j) { gv[j] = *(const f32x4*)(g + 4 * lane + 256 * j); bv[j] = *(const f32x4*)(b + 4 * lane + 256 * j); }
    for (int row = gw; row < MTOK; row += NGW) {
        f32x4* xr = (f32x4*)(X + (size_t)row * 1024) + lane; f32x4 v[4]; float s = 0.f;
#pragma unroll
        for (int j = 0; j < 4; ++j) { v[j] = xr[64 * j]; s += (v[j].x + v[j].y) + (v[j].z + v[j].w); }
        const float mean = wave_sum(s) * (1.f / 1024.f); float s2 = 0.f;
#pragma unroll
        for (int j = 0; j < 4; ++j) { v[j] = v[j] - mean; s2 += (v[j].x * v[j].x + v[j].y * v[j].y) + (v[j].z * v[j].z + v[j].w * v[j].w); }
        const float rstd = 1.f / sqrtf(wave_sum(s2) * (1.f / 1024.f) + 1e-5f);
        if (lane == 0) ST[row] = (f32x2){mean, rstd};
        u32x2* ob = (u32x2*)(XB + (size_t)row * 1024) + lane;
#pragma unroll
        for (int j = 0; j < 4; ++j) { const f32x4 y = v[j] * rstd * gv[j] + bv[j]; if (final_ln) xr[64 * j] = y; u32x2 w; w.x = pk2(y.x, y.y); w.y = pk2(y.z, y.w); ob[64 * j] = w; }
    }
}

DI void lruconv_phase(const Ctx& cx, const Params& p) {
    const bf16_t* P = (const bf16_t*)(p.ws + WS_T); bf16_t* U = (bf16_t*)(p.ws + WS_T + 128 * MiB);
    const float* cw = p.in[6]; const float* cb = p.in[7];
    const int wid = cx.tid >> 6, lane = cx.tid & 63, gw = cx.bid * 8 + wid, NGW = gridDim.x * 8;
    for (int item = gw; item < 2048; item += NGW) {
        const int rb = item >> 1, c0 = (item & 1) * 512 + lane * 8, row0 = rb * 32;
        const V8 w0 = ldf8(cw + c0), w1 = ldf8(cw + 1024 + c0), w2 = ldf8(cw + 2048 + c0), w3 = ldf8(cw + 3072 + c0), bb = ldf8(cb + c0);
        V8 h3, h2, h1; const f32x4 z = {0.f, 0.f, 0.f, 0.f}; h3.a = z; h3.b = z; h2 = h3; h1 = h3;
        const bf16_t* src = P + (size_t)row0 * 2048 + 1024 + c0;
        if ((row0 & (SEQ - 1)) != 0) { h3 = unpack8(*(const u32x4*)(src - 3 * 2048)); h2 = unpack8(*(const u32x4*)(src - 2 * 2048)); h1 = unpack8(*(const u32x4*)(src - 2048)); }
#pragma unroll 4
        for (int r = 0; r < 32; ++r) {
            const V8 cur = unpack8(*(const u32x4*)(src + (size_t)r * 2048));
            V8 y; y.a = bb.a + w0.a * h3.a + w1.a * h2.a + w2.a * h1.a + w3.a * cur.a; y.b = bb.b + w0.b * h3.b + w1.b * h2.b + w2.b * h1.b + w3.b * cur.b;
            *(u32x4*)(U + (size_t)(row0 + r) * 1024 + c0) = pack8(y);
            h3 = h2; h2 = h1; h1 = cur;
        }
    }
}

DI float neg_expm1(float x) {
    if (x > -0.125f) return -x * (1.f + x * (0.5f + x * (0.16666667f + x * (0.041666668f + x * (0.0083333338f + x * 0.0013888889f)))));
    return 1.f - fexp(x);
}
DI float gelu_tanh(float g) { const float z2 = 1.5957691216057308f * (g + 0.044715f * g * g * g); return g * __builtin_amdgcn_rcpf(1.f + fexp(-z2)); }

constexpr int SCH = 32, NCHK = SEQ / SCH;
template <int PASS>
DI void scan_phase(const Ctx& cx, const Params& p) {
    const bf16_t* P = (const bf16_t*)(p.ws + WS_T); const bf16_t* U = (const bf16_t*)(p.ws + WS_T + 128 * MiB);
    const bf16_t* G = (const bf16_t*)(p.ws + WS_T + 192 * MiB); bf16_t* YB = (bf16_t*)(p.ws + WS_T) + 1024;
    float* SP = (float*)(p.ws + WS_T + 320 * MiB); float* SH = (float*)(p.ws + WS_T + 324 * MiB); float* CR = (float*)(p.ws + WS_T + 328 * MiB);
    const float* lam = p.in[12];
    const int wid = __builtin_amdgcn_readfirstlane(cx.tid >> 6), lane = cx.tid & 63, gw = cx.bid * 8 + wid, NGW = gridDim.x * 8;
    for (int item = gw; item < 4 * NCHK * 4; item += NGW) {
        const int hq = item & 3, chunk = (item >> 2) % NCHK, b = item / (4 * NCHK);
        const int c0 = hq * 256 + lane * 4;
        f32x4 spc;
        { const f32x4 lm = *(const f32x4*)(lam + c0);
#pragma unroll
          for (int e = 0; e < 4; ++e) { const float z = -lm[e]; spc[e] = 8.0f * (fmaxf(z, 0.f) + log1pf(fexp(-fabsf(z)))); } }
        const size_t so = (size_t)(b * NCHK + chunk) * 1024 + c0;
        f32x4 hh = {0.f, 0.f, 0.f, 0.f}, pp = {1.f, 1.f, 1.f, 1.f};
        if (PASS == 2) hh = *(const f32x4*)(CR + so);
        const size_t row0 = (size_t)b * SEQ + chunk * SCH;
#pragma unroll 1
        for (int t0 = 0; t0 < SCH; t0 += 8) {
            u32x2 rw[8], iw[8], uw[8], gw2[8];
#pragma unroll
            for (int t = 0; t < 8; ++t) { const size_t row = row0 + t0 + t;
                rw[t] = *(const u32x2*)(G + row * 2048 + hq * 512 + lane * 4); iw[t] = *(const u32x2*)(G + row * 2048 + hq * 512 + 256 + lane * 4);
                uw[t] = *(const u32x2*)(U + row * 1024 + c0); if (PASS == 2) gw2[t] = *(const u32x2*)(P + row * 2048 + c0); }
#pragma unroll
            for (int t = 0; t < 8; ++t) {
                const f32x4 r = {bf_lo(rw[t].x), bf_hi(rw[t].x), bf_lo(rw[t].y), bf_hi(rw[t].y)}, ig = {bf_lo(iw[t].x), bf_hi(iw[t].x), bf_lo(iw[t].y), bf_hi(iw[t].y)}, uu = {bf_lo(uw[t].x), bf_hi(uw[t].x), bf_lo(uw[t].y), bf_hi(uw[t].y)};
                f32x4 a, bi;
#pragma unroll
                for (int e = 0; e < 4; ++e) { const float la = -spc[e] * r[e]; a[e] = fexp(la); bi[e] = sqrtf(fmaxf(neg_expm1(2.f * la), 0.f)) * (ig[e] * uu[e]); }
                hh = a * hh + bi;
                if (PASS == 1) pp *= a;
                else {
                    const f32x4 gt = {bf_lo(gw2[t].x), bf_hi(gw2[t].x), bf_lo(gw2[t].y), bf_hi(gw2[t].y)};
                    u32x2 w; w.x = pk2(hh.x * gelu_tanh(gt.x), hh.y * gelu_tanh(gt.y)); w.y = pk2(hh.z * gelu_tanh(gt.z), hh.w * gelu_tanh(gt.w));
                    *(u32x2*)(YB + (row0 + t0 + t) * 2048 + c0) = w;
                }
            }
        }
        if (PASS == 1) { *(f32x4*)(SP + so) = pp; *(f32x4*)(SH + so) = hh; }
    }
}
DI void scanmid_phase(const Ctx& cx, const Params& p, LAS unsigned char* lds) {
    if (cx.bid >= 32) return;
    const float* SP = (const float*)(p.ws + WS_T + 320 * MiB); const float* SH = (const float*)(p.ws + WS_T + 324 * MiB); float* CR = (float*)(p.ws + WS_T + 328 * MiB);
    const int b = cx.bid >> 3, cq = cx.tid & 31, seg = cx.tid >> 5, c0 = ((cx.bid & 7) * 32 + cq) * 4;
    LAS f32x4* L = (LAS f32x4*)lds;
    f32x4 A = {1.f, 1.f, 1.f, 1.f}, H = {0.f, 0.f, 0.f, 0.f};
    f32x4 a[16], h0[16];
#pragma unroll
    for (int k = 0; k < 16; ++k) { const size_t o = (size_t)(b * NCHK + seg * 16 + k) * 1024 + c0; a[k] = *(const f32x4*)(SP + o); h0[k] = *(const f32x4*)(SH + o); }
#pragma unroll
    for (int k = 0; k < 16; ++k) { H = a[k] * H + h0[k]; A *= a[k]; }
    L[(cq * 16 + seg) * 2] = A; L[(cq * 16 + seg) * 2 + 1] = H;
    __syncthreads();
    f32x4 hc = {0.f, 0.f, 0.f, 0.f};
    for (int s2 = 0; s2 < seg; ++s2) { const f32x4 As = L[(cq * 16 + s2) * 2], Hs = L[(cq * 16 + s2) * 2 + 1]; hc = As * hc + Hs; }
#pragma unroll
    for (int k = 0; k < 16; ++k) { *(f32x4*)(CR + (size_t)(b * NCHK + seg * 16 + k) * 1024 + c0) = hc; hc = a[k] * hc + h0[k]; }
    __syncthreads();
}

DI void glufix_phase(const Ctx& cx, const Params& p, int layer) {
    bf16_t* ACT = (bf16_t*)(p.ws + WS_T); const bf16_t* HF = (const bf16_t*)(p.ws + WS_T + 176 * MiB); const bf16_t* HL = (const bf16_t*)(p.ws + WS_T + 188 * MiB);
    const float* cw = p.in[24] + (size_t)layer * 3 * 5632; const float* cb = p.in[25] + (size_t)layer * 5632;
    const int total = 512 * 2 * 352;
    for (int idx = cx.bid * 512 + cx.tid; idx < total; idx += gridDim.x * 512) {
        const int c = idx % 352, r = (idx / 352) & 1, blk = idx / 704, col = c * 8, row = blk * 64 + r;
        const bool hasprev = ((blk * 64) & (SEQ - 1)) != 0;
        const u32x4 zz = {0u, 0u, 0u, 0u};
        u32x4 g0r = zz, g1r = zz, u0r = zz, u1r = zz;
        const bf16_t* hf = HF + (size_t)(blk * 2) * 5632 + col;
        if (r == 1) { g1r = *(const u32x4*)hf; u1r = *(const u32x4*)(hf + 2816); }
        if (hasprev) {
            const bf16_t* hl = HL + (size_t)((blk - 1) * 2) * 5632 + col;
            if (r == 1) { g0r = *(const u32x4*)(hl + 5632); u0r = *(const u32x4*)(hl + 5632 + 2816); }
            else { g0r = *(const u32x4*)hl; u0r = *(const u32x4*)(hl + 2816); g1r = *(const u32x4*)(hl + 5632); u1r = *(const u32x4*)(hl + 5632 + 2816); }
        }
        const u32x4 gcr = *(const u32x4*)(hf + (size_t)r * 5632), ucr = *(const u32x4*)(hf + (size_t)r * 5632 + 2816);
        const V8 g0 = ldf8(cw + col), g1 = ldf8(cw + 5632 + col), g2 = ldf8(cw + 2 * 5632 + col), gb = ldf8(cb + col);
        const V8 u0 = ldf8(cw + 2816 + col), u1 = ldf8(cw + 5632 + 2816 + col), u2 = ldf8(cw + 2 * 5632 + 2816 + col), ub = ldf8(cb + 2816 + col);
        const V8 gh2 = unpack8(g0r), gh1 = unpack8(g1r), gc = unpack8(gcr), uh2 = unpack8(u0r), uh1 = unpack8(u1r), uc = unpack8(ucr);
        V8 gv, uv, o;
        gv.a = gb.a + g0.a * gh2.a + g1.a * gh1.a + g2.a * gc.a; gv.b = gb.b + g0.b * gh2.b + g1.b * gh1.b + g2.b * gc.b;
        uv.a = ub.a + u0.a * uh2.a + u1.a * uh1.a + u2.a * uc.a; uv.b = ub.b + u0.b * uh2.b + u1.b * uh1.b + u2.b * uc.b;
#pragma unroll
        for (int e = 0; e < 4; ++e) { o.a[e] = gv.a[e] * __builtin_amdgcn_rcpf(1.f + fexp(-gv.a[e])) * uv.a[e]; o.b[e] = gv.b[e] * __builtin_amdgcn_rcpf(1.f + fexp(-gv.b[e])) * uv.b[e]; }
        *(u32x4*)(ACT + (size_t)row * 2816 + col) = pack8(o);
    }
}

DI void mlaprep_phase(const Ctx& cx, const Params& p) {
    const bf16_t* Cc = (const bf16_t*)(p.ws + WS_T); bf16_t* KR = (bf16_t*)(p.ws + WS_T + 272 * MiB);
    float* rsq = (float*)(p.ws + WS_MISC + MS_RSQ); float* rskv = (float*)(p.ws + WS_MISC + MS_RSKV);
    const float* cosT = (const float*)(p.ws + WS_MISC + MS_COS); const float* sinT = (const float*)(p.ws + WS_MISC + MS_SIN);
    const int wid = cx.tid >> 6, lane = cx.tid & 63, gw = cx.bid * 8 + wid, NGW = gridDim.x * 8;
    for (int row = gw; row < MTOK; row += NGW) {
        const bf16_t* src = Cc + (size_t)row * 768;
        const V8 v0 = unpack8(*(const u32x4*)(src + 8 * lane));
        const float ss0 = ((v0.a.x * v0.a.x + v0.a.y * v0.a.y) + (v0.a.z * v0.a.z + v0.a.w * v0.a.w)) + ((v0.b.x * v0.b.x + v0.b.y * v0.b.y) + (v0.b.z * v0.b.z + v0.b.w * v0.b.w));
        float sq = (lane < 48) ? ss0 : 0.f, skv = (lane < 48) ? 0.f : ss0;
        if (lane < 32) {
            const V8 v1 = unpack8(*(const u32x4*)(src + 512 + 8 * lane));
            if (lane < 16) skv += ((v1.a.x * v1.a.x + v1.a.y * v1.a.y) + (v1.a.z * v1.a.z + v1.a.w * v1.a.w)) + ((v1.b.x * v1.b.x + v1.b.y * v1.b.y) + (v1.b.z * v1.b.z + v1.b.w * v1.b.w));
            else if (lane < 24) {
                const int pos = row & (SEQ - 1), f0 = 4 * (lane - 16);
                const f32x4 cs = *(const f32x4*)(cosT + pos * 32 + f0), sn = *(const f32x4*)(sinT + pos * 32 + f0);
                V8 r;
                r.a.x = v1.a.x * cs.x - v1.a.y * sn.x; r.a.y = v1.a.y * cs.x + v1.a.x * sn.x;
                r.a.z = v1.a.z * cs.y - v1.a.w * sn.y; r.a.w = v1.a.w * cs.y + v1.a.z * sn.y;
                r.b.x = v1.b.x * cs.z - v1.b.y * sn.z; r.b.y = v1.b.y * cs.z + v1.b.x * sn.z;
                r.b.z = v1.b.z * cs.w - v1.b.w * sn.w; r.b.w = v1.b.w * cs.w + v1.b.z * sn.w;
                *(u32x4*)(KR + (size_t)row * 64 + 8 * (lane - 16)) = pack8(r);
            }
        }
        sq = wave_sum(sq); skv = wave_sum(skv);
        if (lane == 0) { rsq[row] = 1.f / sqrtf(sq * (1.f / 384.f) + 1e-6f); rskv[row] = 1.f / sqrtf(skv * (1.f / 256.f) + 1e-6f); }
    }
}

DI void swa_phase(const Ctx& cx, const Params& p, int mj, LAS unsigned char* lds) {
    const bf16_t* QKV = (const bf16_t*)(p.ws + WS_T); bf16_t* AO = (bf16_t*)(p.ws + WS_T + 96 * MiB);
    const float* sinks = p.in[3] + mj * 16;
    const int tid = cx.tid, wid = __builtin_amdgcn_readfirstlane(tid >> 6);
    constexpr int KSTR = 144, KBYTES = 64 * KSTR, VSTR = 192, VBYTES = 64 * VSTR;
    for (int item = cx.bid; item < 1024; item += gridDim.x) {
        const int n = item & 63, kvh = (item >> 6) & 3, b = item >> 8;
        const size_t rowbase = (size_t)b * SEQ;
        const bf16_t* Kb = QKV + rowbase * 1536 + 1024 + kvh * 64; const bf16_t* Vb = QKV + rowbase * 1536 + 1280 + kvh * 64;
        const int k_begin = (n > 0 ? n - 1 : 0) * 128, k_end = (n + 1) * 128, nkeys = k_end - k_begin;
        u32x4 kr[4], vr[4];
#pragma unroll
        for (int i = 0; i < 4; ++i) { const int ci = tid + 512 * i, key = ci >> 3, part = ci & 7;
            if (key < nkeys) { kr[i] = *(const u32x4*)(Kb + (size_t)(k_begin + key) * 1536 + part * 8); vr[i] = *(const u32x4*)(Vb + (size_t)(k_begin + key) * 1536 + part * 8); } }
#pragma unroll
        for (int i = 0; i < 4; ++i) { const int ci = tid + 512 * i, key = ci >> 3, part = ci & 7;
            if (key < nkeys) { *(LAS u32x4*)(lds + (key >> 6) * KBYTES + (key & 63) * KSTR + part * 16) = kr[i]; *(LAS u32x4*)(lds + 4 * KBYTES + (key >> 6) * VBYTES + (key & 63) * VSTR + part * 16) = vr[i]; } }
        __syncthreads();
        const int qpos0 = n * 128 + (wid & 3) * 32;
#pragma unroll 1
        for (int half = 0; half < 2; ++half) {
            const int head = kvh * 4 + half * 2 + (wid >> 2);
            attn_block<64, 0, 64, true>(cx, lds, QKV + (rowbase + qpos0) * 1536 + head * 64, 1536, Kb, 1536, Kb, 1536, Vb, 1536, k_begin, k_end, qpos0, 128, 0.125f * LOG2E, sinks[head] * LOG2E, 1.0f,
                                        AO + (rowbase + qpos0) * 1024 + head * 64, 1024);
        }
        __syncthreads();
    }
}
DI void mla_phase(const Ctx& cx, const Params& p, LAS unsigned char* lds) {
    const bf16_t* Qm = (const bf16_t*)(p.ws + WS_T + 48 * MiB); const bf16_t* KV = (const bf16_t*)(p.ws + WS_T + 144 * MiB);
    const bf16_t* KR = (const bf16_t*)(p.ws + WS_T + 272 * MiB); bf16_t* AO = (bf16_t*)(p.ws + WS_T + 276 * MiB);
    const int wid = __builtin_amdgcn_readfirstlane(cx.tid >> 6);
    for (int pid0 = cx.bid; pid0 < 512; pid0 += gridDim.x) {
        const int pid = (gridDim.x == 256) ? ((pid0 & ~255) + (pid0 & 7) * 32 + ((pid0 & 255) >> 3)) : pid0;
        const int bh = pid >> 4, qa = pid & 15, b = bh >> 3, hd = bh & 7;
        const size_t rowbase = (size_t)b * SEQ;
#pragma unroll 1
        for (int sub = 0; sub < 2; ++sub) {
            const int qt = sub ? 31 - qa : qa, qpos0 = qt * 256 + wid * 32;
            attn_block<128, 64, 128>(cx, lds, Qm + (rowbase + qpos0) * 1536 + hd * 192, 1536, KV + rowbase * 2048 + hd * 256, 2048, KR + rowbase * 64, 64,
                                     KV + rowbase * 2048 + hd * 256 + 128, 2048, 0, (qt + 1) * 256, qpos0, 0x40000000, 0.07216878364870322f * LOG2E, -1e30f, 0.f,
                                     AO + (rowbase + qpos0) * 1024 + hd * 128, 1024);
        }
    }
}


#define XB_TMO      128
#define XB_XCNT(j)  (256  + 64 * (j))
#define XB_XSUB(j)  (1280 + 64 * (j))
#define XB_XGEN(j)  (2304 + 64 * (j))
#define XB_TOP      3328
#define XB_TOPGEN   3392
#define XCD_BAR_WORDS 3456
#define XB_SPIN_CAP (1u << 18)
DI unsigned xb_ld(unsigned* p)              { return __hip_atomic_load(p, __ATOMIC_RELAXED, __HIP_MEMORY_SCOPE_AGENT); }
DI unsigned xb_add(unsigned* p, unsigned v) { return __hip_atomic_fetch_add(p, v, __ATOMIC_RELAXED, __HIP_MEMORY_SCOPE_AGENT); }
DI unsigned xb_xcc_id() { return (unsigned)__builtin_amdgcn_s_getreg((3 << 11) | 20) & 0xFu; }
#define XB_SPIN(cond, bar) do { unsigned _sp = 0; while (cond) { __builtin_amdgcn_s_sleep(1); \
    if ((++_sp & 255u) == 0u) { if (xb_ld(&(bar)[XB_TMO])) break; if (_sp > XB_SPIN_CAP) { atomicAdd(&(bar)[XB_TMO], 1u); break; } } } } while (0)
struct XcdBarrier { unsigned* bar; unsigned x; volatile LAS unsigned* st; };
DI XcdBarrier xcd_barrier_post(unsigned* bar, volatile LAS unsigned* st) {
    XcdBarrier b; b.bar = bar; b.x = xb_xcc_id(); b.st = st;
    if (threadIdx.x == 0) (void)xb_add(&bar[XB_XCNT(b.x)], 1u);
    return b;
}
DI void xcd_barrier_complete(unsigned* bar, unsigned x, unsigned& nloc, unsigned& nx) {
    const unsigned G = gridDim.x * gridDim.y * gridDim.z;
    unsigned sum, cnt, mine, sp = 0u;
    for (;;) {
        sum = 0u; cnt = 0u; mine = 0u;
#pragma unroll
        for (unsigned j = 0; j < 16; ++j) { const unsigned c = xb_ld(&bar[XB_XCNT(j)]); sum += c; cnt += (c > 0u) ? 1u : 0u; mine = (j == x) ? c : mine; }
        if (sum == G) break;
        __builtin_amdgcn_s_sleep(1);
        if ((++sp & 255u) == 0u) { if (xb_ld(&bar[XB_TMO])) break; if (sp > XB_SPIN_CAP) { atomicAdd(&bar[XB_TMO], 1u); break; } }
    }
    nloc = mine > 0u ? mine : 1u; nx = cnt > 0u ? cnt : 1u;
}
DI void xcd_barrier(const XcdBarrier& b) {
    asm volatile("s_waitcnt vmcnt(0)" ::: "memory");
    __syncthreads();
    if (threadIdx.x == 0) {
        unsigned* bar = b.bar;
        __builtin_amdgcn_s_waitcnt(0);
        unsigned nloc = b.st[0], nx = b.st[1];
        if (nloc == 0u) { xcd_barrier_complete(bar, b.x, nloc, nx); b.st[0] = nloc; b.st[1] = nx; }
        const unsigned old = xb_add(&bar[XB_XSUB(b.x)], 1u);
        const unsigned gen = old / nloc;
        if (old + 1u == (gen + 1u) * nloc) {
            __builtin_amdgcn_fence(__ATOMIC_RELEASE, "agent");
            asm volatile("s_waitcnt vmcnt(0)" ::: "memory");
            const unsigned og = xb_add(&bar[XB_TOP], 1u);
            const unsigned tg = og / nx;
            if (og + 1u == (tg + 1u) * nx) xb_add(&bar[XB_TOPGEN], 1u);
            else XB_SPIN(xb_ld(&bar[XB_TOPGEN]) == tg, bar);
            __builtin_amdgcn_fence(__ATOMIC_ACQUIRE, "agent");
            xb_add(&bar[XB_XGEN(b.x)], 1u);
            asm volatile("s_waitcnt vmcnt(0)" ::: "memory");
        } else {
            XB_SPIN(xb_ld(&bar[XB_XGEN(b.x)]) == gen, bar);
            __builtin_amdgcn_fence(__ATOMIC_ACQUIRE, "agent");
            asm volatile("s_waitcnt vmcnt(0)" ::: "memory");
        }
    }
    __syncthreads();
}

enum { K_SETUP = 0, K_GEMM, K_SWA, K_MLA, K_LN, K_LRUCONV, K_SCAN1, K_SCAN2, K_GLU, K_MLAPREP, K_DUMP, K_SCANMID };
struct PhaseD { int kind, nosync, layer, arg; GemmD g; };

DI void gd_init(GemmD& g, const void* A, int lda, const void* Bt, int ldb, int M, int N, int K, int epi, void* C, int ldc) {
    g.A = (const bf16_t*)A; g.Bt = (const bf16_t*)Bt; g.lda = lda; g.ldb = ldb; g.M = M; g.N = N; g.K = K; g.G = 1;
    g.sA1 = g.sA2 = g.sB1 = g.sB2 = g.sC1 = g.sC2 = 0; g.epi = epi; g.opt = ROPE_NONE; g.ldc = ldc; g.growstep = 0; g.gshift = 2; g.rot = 0; g.C = C; g.aux0 = nullptr; g.aux1 = nullptr; g.scale = 1.f;
}
#define RES_PREV(sidx) do { const int s_ = (sidx); if (s_ == 0) d.g.aux1 = p.in[0]; d.g.aux0 = (const float*)(MS + MS_SP); d.g.opt = 32 * (s_ + 1); d.g.cosT = p.in[27] + s_ * 1024; d.g.sinT = p.in[28] + s_ * 1024; } while (0)
DI void make_desc(const Params& p, int ph, PhaseD& d) {
    unsigned char* ws = p.ws; unsigned char* T = ws + WS_T; unsigned char* MS = ws + WS_MISC;
    bf16_t* WB = (bf16_t*)(ws + WS_WB); bf16_t* XB = (bf16_t*)(ws + WS_XB);
    d.kind = K_SETUP; d.nosync = 0; d.layer = 0; d.arg = 0;
    gd_init(d.g, XB, 1024, WB, 1024, MTOK, 1024, 1024, EPI_BF16, T, 1024);
    d.g.cosT = (const float*)(MS + MS_COS); d.g.sinT = (const float*)(MS + MS_SIN);
    if (ph == 0) return;
    if (ph == 1) { d.kind = K_GEMM; gd_init(d.g, MS + MS_MEMB, 1024, T, 1024, 1024, 1024, 1024, EPI_BF16, MS + MS_KMEM, 1024); return; }
    if (ph == 2) { d.kind = K_GEMM; d.nosync = 1; gd_init(d.g, MS + MS_MEMB, 1024, T + 2 * MiB, 1024, 1024, 1024, 1024, EPI_BF16, MS + MS_VT, 1024); d.g.rot = 16; return; }
    int q = ph - 3, layer = 0;
    for (;;) { const int k3 = layer % 3, cnt = (k3 == 0 ? 5 : (k3 == 1 ? 9 : 8)) + 5; if (q < cnt) break; q -= cnt; ++layer; }
    const int kind = layer % 3, nm = (kind == 0 ? 5 : (kind == 1 ? 9 : 8));
    d.layer = layer;
    if (q == 1) {
        d.kind = K_GEMM; d.nosync = 1; gd_init(d.g, MS + MS_KMEM, 1024, WB + OFF_XQ, 1024, 256, 1024, 256, EPI_BF16, T + 384 * MiB, 1024);
        d.g.G = 16; d.g.sA1 = 256 * 1024; d.g.sA2 = 256; d.g.sB1 = 0; d.g.sB2 = 256; d.g.sC1 = 1024 * 1024; d.g.sC2 = 256 * 1024; d.g.rot = 192; return; }
    if (q == 2) {
        d.kind = K_GEMM; d.nosync = 1; gd_init(d.g, WB + OFF_XO, 1024, MS + MS_VT, 1024, 1024, 256, 256, EPI_BF16, T + 392 * MiB, 1024);
        d.g.G = 16; d.g.sA1 = 0; d.g.sA2 = 256; d.g.sB1 = 256 * 1024; d.g.sB2 = 256; d.g.sC1 = 1024 * 1024; d.g.sC2 = 256; d.g.rot = 128; return; }
    if (q < nm) {
        if (q > 2) q -= 2;
        if (kind == 0) {
            if (q == 0) { d.kind = K_GEMM; gd_init(d.g, XB, 1024, WB + OFF_M1, 1024, MTOK, 1536, 1024, EPI_BF16, T, 1536); d.g.opt = ROPE_SWA; }
            else if (q == 1) { d.kind = K_SWA; }
            else if (q == 2) { d.kind = K_GEMM; gd_init(d.g, T + 96 * MiB, 1024, WB + OFF_MO, 1024, MTOK, 1024, 1024, EPI_RES, p.out, 1024); RES_PREV(layer * 3 + 0); }
            else { d.kind = K_LN; d.arg = layer * 3 + 0; }
        } else if (kind == 1) {
            if (q == 0) { d.kind = K_GEMM; gd_init(d.g, XB, 1024, WB + OFF_M1, 1024, MTOK, 2048, 1024, EPI_BF16, T, 2048); }
            else if (q == 1) { d.kind = K_LRUCONV; }
            else if (q == 2) { d.kind = K_GEMM; gd_init(d.g, T + 128 * MiB, 1024, WB + OFF_M2, 256, MTOK, 512, 256, EPI_SIG, T + 192 * MiB, 2048);
                               d.g.G = 4; d.g.sA2 = 256; d.g.sB2 = 512 * 256; d.g.sC2 = 512; d.g.aux0 = p.in[9]; d.g.aux1 = p.in[11]; }
            else if (q == 3) { d.kind = K_SCAN1; }
            else if (q == 4) { d.kind = K_SCANMID; }
            else if (q == 5) { d.kind = K_SCAN2; }
            else if (q == 6) { d.kind = K_GEMM; gd_init(d.g, (bf16_t*)T + 1024, 2048, WB + OFF_MO, 1024, MTOK, 1024, 1024, EPI_RES, p.out, 1024); RES_PREV(layer * 3 + 0); }
            else { d.kind = K_LN; d.arg = layer * 3 + 0; }
        } else {
            if (q == 0) { d.kind = K_GEMM; gd_init(d.g, XB, 1024, WB + OFF_M1, 1024, MTOK, 768, 1024, EPI_BF16, T, 768); }
            else if (q == 1) { d.kind = K_MLAPREP; }
            else if (q == 2) { d.kind = K_GEMM; gd_init(d.g, T, 768, WB + OFF_M2, 384, MTOK, 1536, 384, EPI_BF16, T + 48 * MiB, 1536); d.g.opt = ROPE_MLAQ; d.g.aux0 = (const float*)(MS + MS_RSQ); }
            else if (q == 3) { d.kind = K_GEMM; d.nosync = 1; gd_init(d.g, (bf16_t*)T + 384, 768, WB + OFF_M3, 256, MTOK, 2048, 256, EPI_BF16, T + 144 * MiB, 2048); d.g.aux0 = (const float*)(MS + MS_RSKV); }
            else if (q == 4) { d.kind = K_MLA; }
            else if (q == 5) { d.kind = K_GEMM; gd_init(d.g, T + 276 * MiB, 1024, WB + OFF_MO, 1024, MTOK, 1024, 1024, EPI_RES, p.out, 1024); RES_PREV(layer * 3 + 0); }
            else { d.kind = K_LN; d.arg = layer * 3 + 0; }
        }
        return;
    }
    q -= nm;
    if (q < 2) {
        if (q == 0) { d.kind = K_GEMM; gd_init(d.g, XB, 1024, T + 384 * MiB, 1024, SEQ, 1024, 1024, EPI_EXPN, T, 1024);
                      d.g.G = 4; d.g.gshift = 0; d.g.sA1 = (long)SEQ * 1024; d.g.sB1 = 1024 * 1024; d.g.sC1 = (long)SEQ * 1024; d.g.growstep = SEQ; d.g.scale = 0.0625f; }
        else if (q == 1) { d.kind = K_GEMM; gd_init(d.g, T, 1024, T + 392 * MiB, 1024, SEQ, 1024, 1024, EPI_RES, p.out, 1024);
                           d.g.G = 4; d.g.gshift = 0; d.g.sA1 = (long)SEQ * 1024; d.g.sB1 = 1024 * 1024; d.g.growstep = SEQ; RES_PREV(layer * 3 + 1); }
        return;
    }
    q -= 2;
    if (q == 0) { d.kind = K_GEMM; gd_init(d.g, XB, 1024, WB + OFF_FU, 1024, MTOK, 5632, 1024, EPI_GLU, T, 2816);
                  d.g.aux0 = p.in[24] + (size_t)layer * 3 * 5632; d.g.aux1 = p.in[25] + (size_t)layer * 5632; d.g.cosT = (const float*)(T + 176 * MiB); d.g.sinT = (const float*)(T + 188 * MiB); }
    else if (q == 1) { d.kind = K_GLU; }
    else if (q == 2) { d.kind = K_GEMM; gd_init(d.g, T, 2816, WB + OFF_FD, 2816, MTOK, 1024, 2816, EPI_RES, p.out, 1024); RES_PREV(layer * 3 + 2); }
    else { d.kind = K_LN; d.arg = layer * 3 + 2; }
}

__global__ void __launch_bounds__(512) mega(Params p_) {
    extern __shared__ __attribute__((aligned(16))) unsigned char smem[];
    LAS unsigned char* lds = (LAS unsigned char*)smem;
    cg::grid_group grid = cg::this_grid();
    const int ph_lo = p_.ph_lo, ph_hi = p_.ph_hi;
    volatile LAS unsigned* bst = (volatile LAS unsigned*)(lds + 131072);
    if (threadIdx.x == 0) { bst[0] = 0u; bst[1] = 0u; }
    __syncthreads();
    const XcdBarrier xb = xcd_barrier_post((unsigned*)(p_.ws + WS_MISC + MS_BAR), bst);
    for (int it_ = ph_lo; it_ < ph_hi; ++it_) {
#ifdef REP_PH
        const int ph = (it_ > REP_PH) ? it_ - 1 : it_;
#else
        const int ph = it_;
#endif
        int zero; asm volatile("s_mov_b32 %0, 0" : "=s"(zero));
        Ctx cx; cx.tid = threadIdx.x; cx.bid = blockIdx.x; asm volatile("" : "+v"(cx.tid)); asm volatile("" : "+s"(cx.bid));
        const Params& p = *(const Params*)((const char*)&p_ + zero);
        PhaseD d; make_desc(p, ph, d);
        if (it_ > ph_lo && !d.nosync) { if (ph_hi < 0) grid.sync(); else xcd_barrier(xb); }
        switch (d.kind) {
            case K_SETUP: setup_phase(cx, p, lds); break;
            case K_GEMM: gemm_phase(cx, lds, d.g); break;
            case K_SWA: swa_phase(cx, p, d.layer / 3, lds); break;
            case K_MLA: mla_phase(cx, p, lds); break;
            case K_LRUCONV: lruconv_phase(cx, p); break;
            case K_SCAN1: scan_phase<1>(cx, p); break;
            case K_SCAN2: scan_phase<2>(cx, p); break;
            case K_SCANMID: scanmid_phase(cx, p, lds); break;
            case K_GLU: glufix_phase(cx, p, d.layer); convert_set(cx, p, d.layer + 1, lds, 1); break;
            case K_MLAPREP: mlaprep_phase(cx, p); break;
            default: break;
        }
    }
}

extern "C" void kernel_launch(void* const* d_in, const int* in_sizes, int n_in, void* d_out, int out_size, void* d_ws, size_t ws_size, hipStream_t stream) {
    static int grid = 0;
    if (grid == 0) {
        if (n_in != 29 || ws_size < WS_NEED) { fprintf(stderr, "kernel_launch: unexpected n_in %d / ws_size %zu\n", n_in, ws_size); grid = -1; return; }
        int dev = 0, cus = 0, per_cu = 0;
        hipGetDevice(&dev);
        hipDeviceGetAttribute(&cus, hipDeviceAttributeMultiprocessorCount, dev);
        if (hipFuncSetAttribute((const void*)mega, hipFuncAttributeMaxDynamicSharedMemorySize, LDS_BYTES) != hipSuccess) { fprintf(stderr, "kernel_launch: hipFuncSetAttribute failed\n"); }
        if (hipOccupancyMaxActiveBlocksPerMultiprocessor(&per_cu, (const void*)mega, 512, LDS_BYTES) != hipSuccess || per_cu < 1) { fprintf(stderr, "kernel_launch: occupancy query gave %d\n", per_cu); per_cu = 1; }
        (void)hipGetLastError();
        grid = cus * per_cu;
        if (grid > 256) grid = 256;
    }
    if (grid < 0) return;
    (void)hipMemsetAsync((unsigned char*)d_ws + WS_MISC + MS_BAR, 0, 16384 + 32768, stream);
    Params p{};
    for (int i = 0; i < 29; ++i) p.in[i] = (const float*)d_in[i];
    p.out = (float*)d_out; p.ws = (unsigned char*)d_ws;
#if MULTI_LAUNCH
    for (int ph = 0; ph < NPHASES; ++ph) { p.ph_lo = ph; p.ph_hi = ph + 1; hipLaunchKernelGGL(mega, dim3(grid), dim3(512), LDS_BYTES, stream, p); }
#else
#ifdef REP_PH
    p.ph_lo = 0; p.ph_hi = NPHASES + 1;
#else
    p.ph_lo = 0; p.ph_hi = NPHASES;
#endif
    void* args[] = {&p};
    hipError_t e = hipLaunchCooperativeKernel((const void*)mega, dim3(grid), dim3(512), args, LDS_BYTES, stream);
    if (e != hipSuccess) fprintf(stderr, "cooperative launch failed: %s (grid %d)\n", hipGetErrorString(e), grid);
#endif
}
```

```cpp
#include <hip/hip_runtime.h>
#include <hip/hip_cooperative_groups.h>
#include <cstdio>
#include <cstdint>
namespace cg = cooperative_groups;

#ifndef MULTI_LAUNCH
#define MULTI_LAUNCH 0
#endif

#define LAS __attribute__((address_space(3)))
#define DI __device__ __forceinline__
typedef unsigned short bf16_t;
typedef short bf16x8 __attribute__((ext_vector_type(8)));
typedef short s16x4 __attribute__((ext_vector_type(4)));
typedef float f32x2 __attribute__((ext_vector_type(2)));
typedef float f32x4 __attribute__((ext_vector_type(4)));
typedef float f32x16 __attribute__((ext_vector_type(16)));
typedef unsigned u32x2 __attribute__((ext_vector_type(2)));
typedef unsigned u32x4 __attribute__((ext_vector_type(4)));
typedef _Float16 h16x2 __attribute__((ext_vector_type(2)));
typedef _Float16 h16x8 __attribute__((ext_vector_type(8)));

constexpr int SEQ = 8192, MTOK = 32768;
constexpr float ALPHA_F = 1.6817928305074290f;
constexpr float LOG2E = 1.4426950408889634f;
constexpr size_t MiB = (size_t)1 << 20;
constexpr int LDS_BYTES = 131072 + 64 + 10240 + 64;
constexpr int NPHASES = 50;
constexpr size_t WS_WB = 0, WS_MISC = 32 * MiB, WS_XB = 48 * MiB, WS_T = 112 * MiB, WS_NEED = 512 * MiB;
constexpr size_t OFF_M1 = 0, OFF_M2 = (size_t)2 << 20, OFF_M3 = (size_t)3 << 20, OFF_MO = (size_t)4 << 20, OFF_XQ = (size_t)5 << 20,
                 OFF_XO = (size_t)6 << 20, OFF_FU = (size_t)7 << 20, OFF_FD = (size_t)13 << 20;
constexpr size_t MS_COS = 0, MS_SIN = 1 * MiB, MS_MEMB = 2 * MiB, MS_KMEM = 4 * MiB, MS_VT = 6 * MiB, MS_RSQ = 8 * MiB, MS_RSKV = 8 * MiB + 131072,
                 MS_XSUM = 9 * MiB, MS_SP = 11 * MiB, MS_SH = 12 * MiB, MS_BAR = 14 * MiB;

struct Params { const float* in[29]; float* out; unsigned char* ws; int ph_lo, ph_hi; };
struct Ctx { int tid, bid; };

DI unsigned pk2(float a, float b) { f32x2 v = {a, b}; h16x2 r = __builtin_convertvector(v, h16x2); return __builtin_bit_cast(unsigned, r); }
DI float bf_lo(unsigned w) { return (float)__builtin_bit_cast(h16x2, w)[0]; }
DI float bf_hi(unsigned w) { return (float)__builtin_bit_cast(h16x2, w)[1]; }
DI float fexp2(float x) { return __builtin_amdgcn_exp2f(x); }
DI float fexp(float x) { return __builtin_amdgcn_exp2f(x * LOG2E); }
struct V8 { f32x4 a, b; };
DI V8 unpack8(u32x4 w) { V8 r; r.a = (f32x4){bf_lo(w.x), bf_hi(w.x), bf_lo(w.y), bf_hi(w.y)}; r.b = (f32x4){bf_lo(w.z), bf_hi(w.z), bf_lo(w.w), bf_hi(w.w)}; return r; }
DI u32x4 pack8(const V8& v) { u32x4 w; w.x = pk2(v.a.x, v.a.y); w.y = pk2(v.a.z, v.a.w); w.z = pk2(v.b.x, v.b.y); w.w = pk2(v.b.z, v.b.w); return w; }
DI V8 ldf8(const float* p) { V8 r; r.a = *(const f32x4*)p; r.b = *(const f32x4*)(p + 4); return r; }
DI float wave_sum(float v) {
#pragma unroll
    for (int o = 1; o < 64; o <<= 1) v += __shfl_xor(v, o);
    return v;
}
#define LDS_WAIT() asm volatile("s_waitcnt lgkmcnt(0)" ::: "memory")

constexpr int BM = 256, BK = 64, HALF = 128, HTB = HALF * BK * 2;
enum { EPI_BF16 = 0, EPI_RES = 1, EPI_SIG = 2, EPI_EXP = 3, EPI_DIV = 4, EPI_GLU = 5, EPI_EXPN = 6 };
constexpr size_t MS_CNT = 14 * MiB + 16384;
enum { ROPE_NONE = 0, ROPE_SWA = 1, ROPE_MLAQ = 2 };
struct GemmD {
    const bf16_t* A; const bf16_t* Bt; int lda, ldb, M, N, K, G;
    long sA1, sA2, sB1, sB2, sC1, sC2;
    int epi, opt, ldc, growstep, gshift, rot;
    void* C; const float* aux0; const float* aux1; const float* cosT; const float* sinT; float scale;
};
struct Unit { int pm, pn, g; };

DI int lds_byte(int r, int c) { const int st = (r >> 4) * 2 + (c >> 5), rr = r & 15, cc = c & 31, ob = rr * 64 + cc * 2; return st * 1024 + (ob ^ (((ob >> 9) & 1) << 5)); }
DI void stage_rc(int b, int& R, int& C) { const int st = b / 1024, sb = b % 1024, swz = sb ^ (((sb >> 9) & 1) << 5); R = (st >> 1) * 16 + swz / 64; C = (st & 1) * 32 + (swz % 64) / 2; }
DI int perm32(int rho) { const int n = rho >> 4, i = rho & 15; return 8 * (i >> 2) + 4 * n + (i & 3); }

DI bool next_unit(const Ctx& cx, const GemmD& g, int i, Unit& u) {
    const int nM = g.M >> 8, nN = g.N >> 8, nwg1 = nM * nN, nwg = nwg1 * g.G;
    const int G_ = (int)gridDim.x; int vb = cx.bid - g.rot; if (vb < 0) vb += G_;
    const long L = (long)i * G_ + vb; if (L >= nwg) return false;
    int wgid = (int)L; { const int q = nwg / 8, r = nwg % 8, xcd = wgid % 8, off = wgid / 8; wgid = (xcd < r ? xcd * (q + 1) : r * (q + 1) + (xcd - r) * q) + off; }
    u.g = wgid / nwg1; wgid -= u.g * nwg1;
    const int nig = 8 * nN, gid = wgid / nig, fm = gid * 8, gsz = (nM - fm) < 8 ? (nM - fm) : 8;
    u.pm = fm + ((wgid % nig) % gsz); u.pn = (wgid % nig) / gsz; return true;
}

DI void gemm_epilogue(const GemmD& g, f32x4 (&acc)[2][2][4][2], const Unit& u, int wr, int wc, int fr_, int fq_, LAS unsigned char* lds) {
    int fr = fr_, fq = fq_; asm volatile("" : "+v"(fr), "+v"(fq));
    const int g1 = u.g >> g.gshift, g2 = u.g & ((1 << g.gshift) - 1);
    const int lrow0 = u.pm * BM + wr * 64 + fr;
    if (g.epi == EPI_RES) {
        float* C = (float*)g.C; const float* R = g.aux1 ? g.aux1 : (const float*)g.C;
        unsigned long long* xbuf = (unsigned long long*)g.aux0; unsigned* cnt = (unsigned*)((unsigned char*)g.aux0 + (MS_CNT - MS_SP)); bf16_t* XBo = (bf16_t*)((unsigned char*)g.aux0 + (WS_XB - WS_MISC - MS_SP));
        const unsigned want = (unsigned)g.opt;
        const int col0 = u.pn * BM + wc * 32 + 4 * fq;
        const int grow_t = g1 * g.growstep + u.pm * BM, panel = grow_t >> 8;
        const int wid = wr * 4 + wc, lane = fq * 16 + fr;
        LAS f32x2* P = (LAS f32x2*)(lds + 131072 + 64);
        LAS f32x2* S = (LAS f32x2*)(lds + 131072 + 64 + 8192);
#pragma unroll
        for (int ai = 0; ai < 2; ++ai)
#pragma unroll
            for (int m = 0; m < 4; ++m) {
                const int lr = ai * HALF + wr * 64 + m * 16 + fr; const float* rp = R + (size_t)(grow_t + lr) * g.ldc + col0;
                float sm = 0.f;
#pragma unroll
                for (int bj = 0; bj < 2; ++bj) {
#pragma unroll
                    for (int n = 0; n < 2; ++n) { const f32x4 x = *(const f32x4*)(rp + bj * HALF + n * 16); const f32x4 v = x * ALPHA_F + acc[ai][bj][m][n]; acc[ai][bj][m][n] = v; sm += (v[0] + v[1]) + (v[2] + v[3]); } }
                sm += __shfl_xor(sm, 16); sm += __shfl_xor(sm, 32);
                const float mw = sm * (1.0f / 64.0f); float q = 0.f;
#pragma unroll
                for (int bj = 0; bj < 2; ++bj)
#pragma unroll
                    for (int n = 0; n < 2; ++n) { const f32x4 dd = acc[ai][bj][m][n] - mw; q += (dd[0] * dd[0] + dd[1] * dd[1]) + (dd[2] * dd[2] + dd[3] * dd[3]); }
                q += __shfl_xor(q, 16); q += __shfl_xor(q, 32);
                if (fq == 0) P[lr * 4 + wc] = (f32x2){mw, q};
                if (m & 1) asm volatile("" ::: "memory");
            }
        asm volatile("s_waitcnt lgkmcnt(0)" ::: "memory"); __builtin_amdgcn_s_barrier(); asm volatile("" ::: "memory");
        const int prow = wid * 32 + (lane & 31);
        if (lane < 32) {
            const f32x2 a = P[prow * 4 + 0], b = P[prow * 4 + 1], c = P[prow * 4 + 2], d4 = P[prow * 4 + 3];
            const float mt = (a.x + b.x + c.x + d4.x) * 0.25f;
            const float da = a.x - mt, db = b.x - mt, dc = c.x - mt, dd = d4.x - mt;
            const float m2 = (a.y + b.y) + (c.y + d4.y) + 64.0f * ((da * da + db * db) + (dc * dc + dd * dd));
            __hip_atomic_store(xbuf + ((size_t)(grow_t + prow) * 4 + u.pn), ((unsigned long long)__float_as_uint(m2) << 32) | __float_as_uint(mt), __ATOMIC_RELAXED, __HIP_MEMORY_SCOPE_AGENT);
        }
        asm volatile("s_waitcnt vmcnt(0)" ::: "memory");
        if (lane == 0) __hip_atomic_fetch_add(cnt + 64 * panel, 1u, __ATOMIC_RELAXED, __HIP_MEMORY_SCOPE_AGENT);
        if (wid == 0) {
            unsigned spins = 0;
            while ((unsigned)__builtin_amdgcn_readfirstlane(__hip_atomic_load(cnt + 64 * panel, __ATOMIC_RELAXED, __HIP_MEMORY_SCOPE_AGENT)) < want) { __builtin_amdgcn_s_sleep(2); if (++spins > (1u << 22)) break; }
            __builtin_amdgcn_fence(__ATOMIC_ACQUIRE, "agent");
        }
        asm volatile("s_waitcnt vmcnt(0) lgkmcnt(0)" ::: "memory"); __builtin_amdgcn_s_barrier(); asm volatile("" ::: "memory");
        if (lane < 32) {
            const unsigned long long* slot = xbuf + (size_t)(grow_t + prow) * 4; float mt[4], m2[4]; float ms = 0.f;
#pragma unroll
            for (int t = 0; t < 4; ++t) { const unsigned long long w = __hip_atomic_load(slot + t, __ATOMIC_RELAXED, __HIP_MEMORY_SCOPE_AGENT); mt[t] = __uint_as_float((unsigned)w); m2[t] = __uint_as_float((unsigned)(w >> 32)); ms += mt[t]; }
            const float mean = ms * 0.25f; float q = 0.f;
#pragma unroll
            for (int t = 0; t < 4; ++t) { const float dm = mt[t] - mean; q += m2[t] + 256.0f * dm * dm; }
            S[prow] = (f32x2){mean, 1.0f / sqrtf(q * (1.0f / 1024.0f) + 1e-5f)};
        }
        asm volatile("s_waitcnt lgkmcnt(0)" ::: "memory"); __builtin_amdgcn_s_barrier(); asm volatile("" ::: "memory");
        const float* lg = g.cosT + col0; const float* lb = g.sinT + col0;
#pragma unroll
        for (int ai = 0; ai < 2; ++ai)
#pragma unroll
            for (int m = 0; m < 4; ++m) {
                const int lr = ai * HALF + wr * 64 + m * 16 + fr; const f32x2 sr = S[lr];
                float* cp = C + (size_t)(grow_t + lr) * g.ldc + col0; bf16_t* xp = XBo + (size_t)(grow_t + lr) * g.ldc + col0;
#pragma unroll
                for (int bj = 0; bj < 2; ++bj)
#pragma unroll
                    for (int n = 0; n < 2; ++n) {
                        const f32x4 gvv = *(const f32x4*)(lg + bj * HALF + n * 16), bvv = *(const f32x4*)(lb + bj * HALF + n * 16);
                        const f32x4 y = (acc[ai][bj][m][n] - sr.x) * sr.y * gvv + bvv;
                        *(f32x4*)(cp + bj * HALF + n * 16) = y;
                        u32x2 w; w.x = pk2(y[0], y[1]); w.y = pk2(y[2], y[3]); *(u32x2*)(xp + bj * HALF + n * 16) = w;
                    }
                asm volatile("" ::: "memory");
            }
        return;
    }
    if (g.epi == EPI_EXPN) {
        LAS float* X = (LAS float*)(lds + 131072 + 64);
        const float sc = g.scale * LOG2E;
#pragma unroll
        for (int ai = 0; ai < 2; ++ai)
#pragma unroll
            for (int m = 0; m < 4; ++m) {
                float rsum = 0.f;
#pragma unroll
                for (int bj = 0; bj < 2; ++bj)
#pragma unroll
                    for (int n = 0; n < 2; ++n) {
#pragma unroll
                        for (int j = 0; j < 4; ++j) { const float e = fexp2(fminf(acc[ai][bj][m][n][j] * sc - 5.77f, 15.9f)); rsum += e; } }
                rsum += __shfl_xor(rsum, 16); rsum += __shfl_xor(rsum, 32);
                if (fq == 0) X[(ai * HALF + wr * 64 + m * 16 + fr) * 4 + wc] = rsum;
                __builtin_amdgcn_sched_barrier(0);
            }
        asm volatile("s_waitcnt lgkmcnt(0)" ::: "memory"); __builtin_amdgcn_s_barrier(); asm volatile("" ::: "memory");
    }
    if (g.epi == EPI_GLU) {
        bf16_t* ACT = (bf16_t*)g.C; bf16_t* HF = (bf16_t*)g.cosT; bf16_t* HL = (bf16_t*)g.sinT;
        const float* cw = g.aux0; const float* cb = g.aux1;
        const int ch0 = u.pn * 128 + wc * 32 + 8 * fq;
        f32x4 wg[2][3], wu[2][3], bgv[2], buv[2];
#pragma unroll
        for (int n = 0; n < 2; ++n) {
#pragma unroll
            for (int k = 0; k < 3; ++k) { wg[n][k] = *(const f32x4*)(cw + k * 5632 + ch0 + 4 * n); wu[n][k] = *(const f32x4*)(cw + k * 5632 + 2816 + ch0 + 4 * n); }
            bgv[n] = *(const f32x4*)(cb + ch0 + 4 * n); buv[n] = *(const f32x4*)(cb + 2816 + ch0 + 4 * n);
        }
#pragma unroll
        for (int ai = 0; ai < 2; ++ai) {
            const int rbase = u.pm * BM + ai * HALF + wr * 64, blk = rbase >> 6;
#pragma unroll
            for (int m = 0; m < 4; ++m) {
                const int row = rbase + 16 * m + fr;
                f32x4 o[2];
#pragma unroll
                for (int n = 0; n < 2; ++n) {
                    const f32x4 G = acc[ai][0][m][n], U = acc[ai][1][m][n];
                    f32x4 Gp = {0.f, 0.f, 0.f, 0.f}, Up = Gp;
                    if (m > 0) { Gp = acc[ai][0][m > 0 ? m - 1 : 0][n]; Up = acc[ai][1][m > 0 ? m - 1 : 0][n]; }
                    f32x4 g1, g2, u1, u2;
#pragma unroll
                    for (int j = 0; j < 4; ++j) {
                        const int gi = __float_as_int(G[j]), gpi = __float_as_int(Gp[j]), ui = __float_as_int(U[j]), upi = __float_as_int(Up[j]);
                        g1[j] = __int_as_float(__builtin_amdgcn_update_dpp(__builtin_amdgcn_update_dpp(0, gpi, 0x121, 0xf, 0xf, false), gi, 0x111, 0xf, 0xf, false));
                        g2[j] = __int_as_float(__builtin_amdgcn_update_dpp(__builtin_amdgcn_update_dpp(0, gpi, 0x122, 0xf, 0xf, false), gi, 0x112, 0xf, 0xf, false));
                        u1[j] = __int_as_float(__builtin_amdgcn_update_dpp(__builtin_amdgcn_update_dpp(0, upi, 0x121, 0xf, 0xf, false), ui, 0x111, 0xf, 0xf, false));
                        u2[j] = __int_as_float(__builtin_amdgcn_update_dpp(__builtin_amdgcn_update_dpp(0, upi, 0x122, 0xf, 0xf, false), ui, 0x112, 0xf, 0xf, false));
                    }
                    const f32x4 gv = bgv[n] + wg[n][0] * g2 + wg[n][1] * g1 + wg[n][2] * G;
                    const f32x4 uv = buv[n] + wu[n][0] * u2 + wu[n][1] * u1 + wu[n][2] * U;
#pragma unroll
                    for (int j = 0; j < 4; ++j) o[n][j] = gv[j] * __builtin_amdgcn_rcpf(1.f + fexp(-gv[j])) * uv[j];
                }
                u32x4 w; w.x = pk2(o[0][0], o[0][1]); w.y = pk2(o[0][2], o[0][3]); w.z = pk2(o[1][0], o[1][1]); w.w = pk2(o[1][2], o[1][3]);
                *(u32x4*)(ACT + (size_t)row * 2816 + ch0) = w;
                if ((m == 0 && fr < 2) || (m == 3 && fr >= 14)) {
                    bf16_t* dst = (m == 0 ? HF + (size_t)(blk * 2 + fr) * 5632 : HL + (size_t)(blk * 2 + fr - 14) * 5632) + ch0;
                    const f32x4 G0 = acc[ai][0][m][0], G1 = acc[ai][0][m][1], U0 = acc[ai][1][m][0], U1 = acc[ai][1][m][1];
                    u32x4 wgp, wup; wgp.x = pk2(G0[0], G0[1]); wgp.y = pk2(G0[2], G0[3]); wgp.z = pk2(G1[0], G1[1]); wgp.w = pk2(G1[2], G1[3]);
                    wup.x = pk2(U0[0], U0[1]); wup.y = pk2(U0[2], U0[3]); wup.z = pk2(U1[0], U1[1]); wup.w = pk2(U1[2], U1[3]);
                    *(u32x4*)dst = wgp; *(u32x4*)(dst + 2816) = wup;
                }
            }
        }
        return;
    }
    bf16_t* C = (bf16_t*)g.C + (g1 * g.sC1 + g2 * g.sC2);
    const int grow0 = g1 * g.growstep + lrow0;
    const int col0 = u.pn * BM + wc * 32 + 8 * fq;
#pragma unroll
    for (int ai = 0; ai < 2; ++ai)
#pragma unroll
        for (int m = 0; m < 4; ++m) {
            const int lrow = lrow0 + ai * HALF + m * 16, grow = grow0 + ai * HALF + m * 16;
            bf16_t* rowp = C + (size_t)lrow * g.ldc + col0;
            float rs = 1.f;
            if (g.epi == EPI_BF16) { if (g.aux0) rs = g.aux0[grow]; }
            else if (g.epi == EPI_EXPN) { const f32x4 x4 = *(const LAS f32x4*)((LAS float*)(lds + 131072 + 64) + (ai * HALF + wr * 64 + m * 16 + fr) * 4); rs = __builtin_amdgcn_rcpf((x4.x + x4.y) + (x4.z + x4.w)); }
#pragma unroll
            for (int bj = 0; bj < 2; ++bj) {
                f32x4 v0 = acc[ai][bj][m][0], v1 = acc[ai][bj][m][1];
                const int col = col0 + bj * HALF;
                if (g.epi == EPI_EXPN) {
                    const float sc = g.scale * LOG2E;
#pragma unroll
                    for (int j = 0; j < 4; ++j) { v0[j] = fexp2(fminf(v0[j] * sc - 5.77f, 15.9f)) * rs; v1[j] = fexp2(fminf(v1[j] * sc - 5.77f, 15.9f)) * rs; }
                } else if (g.epi == EPI_BF16) {
                    v0 *= rs; v1 *= rs;
                    bool dorope = false; int f0 = 0;
                    if (g.opt == ROPE_SWA) { dorope = col < 1280; f0 = (col & 63) >> 1; }
                    else if (g.opt == ROPE_MLAQ) { const int hc = col % 192; dorope = hc >= 128; f0 = (hc - 128) >> 1; }
                    if (dorope) {
                        const int pos = grow & (SEQ - 1);
                        const f32x4 cs = *(const f32x4*)(g.cosT + pos * 32 + f0), sn = *(const f32x4*)(g.sinT + pos * 32 + f0);
                        f32x4 r0, r1;
                        r0.x = v0.x * cs.x - v0.y * sn.x; r0.y = v0.y * cs.x + v0.x * sn.x;
                        r0.z = v0.z * cs.y - v0.w * sn.y; r0.w = v0.w * cs.y + v0.z * sn.y;
                        r1.x = v1.x * cs.z - v1.y * sn.z; r1.y = v1.y * cs.z + v1.x * sn.z;
                        r1.z = v1.z * cs.w - v1.w * sn.w; r1.w = v1.w * cs.w + v1.z * sn.w;
                        v0 = r0; v1 = r1;
                    }
                } else if (g.epi == EPI_SIG) {
                    const float* bp = (col < 256) ? (g.aux0 + g2 * 256 + col) : (g.aux1 + g2 * 256 + col - 256);
                    const f32x4 b0 = *(const f32x4*)bp, b1 = *(const f32x4*)(bp + 4);
                    v0 += b0; v1 += b1;
#pragma unroll
                    for (int j = 0; j < 4; ++j) { v0[j] = 1.0f / (1.0f + fexp(-v0[j])); v1[j] = 1.0f / (1.0f + fexp(-v1[j])); }
                }
                u32x4 w; w.x = pk2(v0[0], v0[1]); w.y = pk2(v0[2], v0[3]); w.z = pk2(v1[0], v1[1]); w.w = pk2(v1[2], v1[3]);
                *(u32x4*)(rowp + bj * HALF) = w;
            }
        }
}

DI void gemm_phase(const Ctx& cx, LAS unsigned char* lds, const GemmD& g) {
    const int tid = cx.tid, wid = __builtin_amdgcn_readfirstlane(tid >> 6), lane = tid & 63, wr = wid >> 2, wc = wid & 3, fr = lane & 15, fq = lane >> 4;
    const int K = g.K, nt = K / BK;
    const bool PERM = (g.epi != EPI_RES);
    unsigned voffA[2], voffB[2];
#pragma unroll
    for (int i = 0; i < 2; ++i) { int R, C; stage_rc(tid * 16 + i * 8192, R, C); const int Rb = PERM ? ((R & ~31) + perm32(R & 31)) : R;
        voffA[i] = (unsigned)(R * g.lda + C) * 2u; voffB[i] = (unsigned)(Rb * g.ldb + C) * 2u; }
    const size_t kstep = (size_t)(BK * 2);
    const size_t hstepA = (size_t)HALF * g.lda * 2, hstepB = (size_t)HALF * g.ldb * 2;
    const unsigned ldsw = (unsigned)wid * 1024u;
    const int aoff = lds_byte(wr * 64 + fr, fq * 8), boff = lds_byte(wc * 32 + fr, fq * 8);
#define PG8_SA(b, h) (((b) * 2 + (h)) * HTB)
#define PG8_SB(b, h) ((4 + (b) * 2 + (h)) * HTB)
#define PG8_STAGE(bufoff, gbase, voff) do { _Pragma("unroll") for (int _i = 0; _i < 2; ++_i) \
        __builtin_amdgcn_global_load_lds((const unsigned*)((const char*)(gbase) + (voff)[_i]), (LAS unsigned*)(lds + (bufoff) + ldsw + _i * 8192), 16, 0, 0); } while (0)
#define PG8_LDA(dst, b, h) do { _Pragma("unroll") for (int m = 0; m < 4; ++m) _Pragma("unroll") for (int k = 0; k < 2; ++k) dst[m][k] = *(const LAS bf16x8*)(lds + PG8_SA(b, h) + aoff + m * 2048 + k * 1024); } while (0)
#define PG8_LDB(dst, b, h) do { _Pragma("unroll") for (int n = 0; n < 2; ++n) _Pragma("unroll") for (int k = 0; k < 2; ++k) dst[n][k] = *(const LAS bf16x8*)(lds + PG8_SB(b, h) + boff + n * 2048 + k * 1024); } while (0)
#define PG8_MMA(ai, bj, At, Bt) do { __builtin_amdgcn_s_setprio(1); _Pragma("unroll") for (int m = 0; m < 4; ++m) _Pragma("unroll") for (int n = 0; n < 2; ++n) _Pragma("unroll") for (int k = 0; k < 2; ++k) \
        acc[ai][bj][m][n] = __builtin_amdgcn_mfma_f32_16x16x32_f16(__builtin_bit_cast(h16x8, Bt[n][k]), __builtin_bit_cast(h16x8, At[m][k]), acc[ai][bj][m][n], 0, 0, 0); __builtin_amdgcn_s_setprio(0); } while (0)
#define PG8_WAIT_V(n) asm volatile("s_waitcnt vmcnt(" #n ")" ::: "memory")
#define PG8_WAIT_L(n) asm volatile("s_waitcnt lgkmcnt(" #n ")" ::: "memory")
#define PG8_BAR __builtin_amdgcn_s_barrier()
#define PG8_SCHED __builtin_amdgcn_sched_barrier(0)
    Unit cur, nxt; int ui = 0;
    if (!next_unit(cx, g, 0, cur)) return;
    f32x4 acc[2][2][4][2];
#pragma unroll
    for (int a = 0; a < 2; ++a)
#pragma unroll
        for (int b = 0; b < 2; ++b)
#pragma unroll
            for (int m = 0; m < 4; ++m)
#pragma unroll
                for (int n = 0; n < 2; ++n) acc[a][b][m][n] = (f32x4){0.f, 0.f, 0.f, 0.f};
    bf16x8 At[4][2], B0[2][2], B1[2][2];
    const char* cA = (const char*)g.A + 2 * ((cur.g >> g.gshift) * g.sA1 + (cur.g & ((1 << g.gshift) - 1)) * g.sA2 + (long)cur.pm * BM * g.lda);
    const char* cB = (const char*)g.Bt + 2 * ((cur.g >> g.gshift) * g.sB1 + (cur.g & ((1 << g.gshift) - 1)) * g.sB2 + (long)cur.pn * BM * g.ldb);
    PG8_STAGE(PG8_SB(0, 0), cB, voffB); PG8_STAGE(PG8_SB(0, 1), cB + hstepB, voffB); PG8_STAGE(PG8_SA(0, 0), cA, voffA); PG8_STAGE(PG8_SA(0, 1), cA + hstepA, voffA);
    if (wr == 1) PG8_BAR;
    PG8_WAIT_V(2); PG8_BAR;
    PG8_STAGE(PG8_SB(1, 0), cB + kstep, voffB); PG8_STAGE(PG8_SA(1, 0), cA + kstep, voffA); PG8_STAGE(PG8_SB(1, 1), cB + hstepB + kstep, voffB);
    PG8_WAIT_V(6); PG8_BAR;
    for (;;) {
        const bool has_next = next_unit(cx, g, ui + 1, nxt);
        const char* nA = has_next ? (const char*)g.A + 2 * ((nxt.g >> g.gshift) * g.sA1 + (nxt.g & ((1 << g.gshift) - 1)) * g.sA2 + (long)nxt.pm * BM * g.lda) : cA;
        const char* nB = has_next ? (const char*)g.Bt + 2 * ((nxt.g >> g.gshift) * g.sB1 + (nxt.g & ((1 << g.gshift) - 1)) * g.sB2 + (long)nxt.pn * BM * g.ldb) : cB;
        for (int t = 0; t < nt; t += 2) {
            const bool last = (t == nt - 2);
            const char* a1 = cA + (size_t)(t + 1) * kstep;
            const char* a2 = last ? nA : cA + (size_t)(t + 2) * kstep; const char* b2 = last ? nB : cB + (size_t)(t + 2) * kstep;
            const char* a3 = a2 + kstep; const char* b3 = b2 + kstep;
            PG8_LDB(B0, 0, 0); PG8_LDB(B1, 0, 1); PG8_SCHED; PG8_LDA(At, 0, 0); PG8_STAGE(PG8_SA(1, 1), a1 + hstepA, voffA);
            PG8_WAIT_V(8); PG8_WAIT_L(0); PG8_BAR; PG8_MMA(0, 0, At, B0); PG8_MMA(0, 1, At, B1); PG8_BAR; PG8_SCHED;
            PG8_LDA(At, 0, 1); PG8_STAGE(PG8_SB(0, 0), b2, voffB); PG8_STAGE(PG8_SB(0, 1), b2 + hstepB, voffB); PG8_STAGE(PG8_SA(0, 0), a2, voffA);
            PG8_WAIT_V(8); PG8_WAIT_L(0); PG8_BAR; PG8_MMA(1, 0, At, B0); PG8_MMA(1, 1, At, B1); PG8_BAR; PG8_SCHED;
            PG8_LDB(B0, 1, 0); PG8_LDB(B1, 1, 1); PG8_SCHED; PG8_LDA(At, 1, 0); PG8_STAGE(PG8_SA(0, 1), a2 + hstepA, voffA);
            PG8_WAIT_V(8); PG8_WAIT_L(0); PG8_BAR; PG8_MMA(0, 0, At, B0); PG8_MMA(0, 1, At, B1); PG8_BAR; PG8_SCHED;
            PG8_LDA(At, 1, 1); PG8_STAGE(PG8_SB(1, 0), b3, voffB); PG8_STAGE(PG8_SB(1, 1), b3 + hstepB, voffB); PG8_STAGE(PG8_SA(1, 0), a3, voffA);
            PG8_WAIT_V(8); PG8_WAIT_L(0); PG8_BAR; PG8_MMA(1, 0, At, B0); PG8_MMA(1, 1, At, B1); PG8_BAR; PG8_SCHED;
        }
        if (wr == 0) PG8_BAR;
        gemm_epilogue(g, acc, cur, wr, wc, fr, fq, lds);
        if (!has_next) break;
#pragma unroll
        for (int a = 0; a < 2; ++a)
#pragma unroll
            for (int b = 0; b < 2; ++b)
#pragma unroll
                for (int m = 0; m < 4; ++m)
#pragma unroll
                    for (int n = 0; n < 2; ++n) acc[a][b][m][n] = (f32x4){0.f, 0.f, 0.f, 0.f};
        cur = nxt; cA = nA; cB = nB; ++ui;
        if (wr == 1) PG8_BAR;
    }
    PG8_WAIT_V(0);
    PG8_BAR;
#undef PG8_SA
#undef PG8_SB
#undef PG8_STAGE
#undef PG8_LDA
#undef PG8_LDB
#undef PG8_MMA
#undef PG8_WAIT_V
#undef PG8_WAIT_L
#undef PG8_BAR
#undef PG8_SCHED
}

#define MFMA32(a, b, c) __builtin_amdgcn_mfma_f32_32x32x16_f16(__builtin_bit_cast(h16x8, (a)), __builtin_bit_cast(h16x8, (b)), (c), 0, 0, 0)
template <int DN, int DR, int DV, bool RES = false>
DI void attn_block(const Ctx& cx, LAS unsigned char* lds, const bf16_t* Qw, int ldq, const bf16_t* Kb, int ldk, const bf16_t* Krb, int ldkr,
                   const bf16_t* Vb, int ldv, int k_begin, int k_end, int qpos0, int window, float scale2, float m0, float l0, bf16_t* Ow, int ldo) {
    constexpr int DQK = DN + DR, KS = DQK / 16, KSTR = (DQK + 8) * 2, VSTR = (DV == 128 ? 320 : 192), KBYTES = 64 * KSTR, VBYTES = 64 * VSTR, NDT = DV / 32;
    const int tid = cx.tid, lane = tid & 63, h = lane >> 5, c = lane & 31;
    const bool late = !RES && __builtin_amdgcn_readfirstlane(tid >> 6) >= 4;
    bf16x8 q[KS];
#pragma unroll
    for (int kk = 0; kk < KS; ++kk) q[kk] = *(const bf16x8*)(Qw + (size_t)c * ldq + 16 * kk + 8 * h);
    f32x16 o[NDT];
#pragma unroll
    for (int dt = 0; dt < NDT; ++dt)
#pragma unroll
        for (int j = 0; j < 16; ++j) o[dt][j] = 0.f;
    float m = m0, l = (h == 0) ? l0 : 0.f;
    constexpr int NCH = DN / 8, NKN = DN / 64, KPI = 512 / NCH;
    constexpr int VCH = DV / 8, NVL = DV / 64, VPI = 512 / VCH;
    u32x4 kreg[NKN], vreg[NVL], rreg;
    const unsigned kgo = (unsigned)(((tid / NCH) * ldk + (tid % NCH) * 8) * 2), klo = (unsigned)((tid / NCH) * KSTR + (tid % NCH) * 16);
    const unsigned vgo = (unsigned)(((tid / VCH) * ldv + (tid % VCH) * 8) * 2), vlo = (unsigned)((tid / VCH) * VSTR + (tid % VCH) * 16);
    const unsigned vrd = (unsigned)((4 * h + ((lane & 15) >> 2)) * VSTR + (16 * ((lane >> 4) & 1) + 4 * (lane & 3)) * 2);
    const unsigned rgo = (unsigned)(((tid >> 3) * ldkr + (tid & 7) * 8) * 2), rlo = (unsigned)((tid >> 3) * KSTR + DN * 2 + (tid & 7) * 16);
    const int ntiles = (k_end - k_begin) >> 6;
#define ATT_GLOAD(k0_) do { const char* kb_ = (const char*)(Kb + (size_t)(k0_) * ldk); const char* vb_ = (const char*)(Vb + (size_t)(k0_) * ldv); \
        _Pragma("unroll") for (int i = 0; i < NKN; ++i) kreg[i] = *(const u32x4*)(kb_ + (size_t)i * KPI * ldk * 2 + kgo); \
        _Pragma("unroll") for (int i = 0; i < NVL; ++i) vreg[i] = *(const u32x4*)(vb_ + (size_t)i * VPI * ldv * 2 + vgo); \
        if (DR > 0) rreg = *(const u32x4*)((const char*)(Krb + (size_t)(k0_) * ldkr) + rgo); } while (0)
#define ATT_LSTORE(kb_, vb_) do { LAS unsigned char* Kt_ = lds + (kb_) * KBYTES; LAS unsigned char* Vt_ = lds + VBASE + (vb_) * VBYTES; \
        _Pragma("unroll") for (int i = 0; i < NKN; ++i) *(LAS u32x4*)(Kt_ + i * KPI * KSTR + klo) = kreg[i]; \
        if (DR > 0) *(LAS u32x4*)(Kt_ + rlo) = rreg; \
        _Pragma("unroll") for (int i = 0; i < NVL; ++i) *(LAS u32x4*)(Vt_ + i * VPI * VSTR + vlo) = vreg[i]; } while (0)
    u32x4 pw[4];
    float alpha = 1.f; bool pend = false;
#define ATT_PV(vb_) do { const LAS unsigned char* Vt = lds + VBASE + (vb_) * VBYTES; \
        _Pragma("unroll") for (int dt = 0; dt < NDT; ++dt) _Pragma("unroll") for (int j = 0; j < 16; ++j) o[dt][j] *= alpha; \
        _Pragma("unroll") for (int ss = 0; ss < 4; ++ss) { const bf16x8 pf = __builtin_bit_cast(bf16x8, pw[ss]); \
            _Pragma("unroll") for (int dt = 0; dt < NDT; ++dt) { \
                LAS unsigned char* vp = (LAS unsigned char*)Vt + vrd + ((ss >> 1) * 32 + 16 * (ss & 1)) * VSTR + dt * 64; \
                const s16x4 lo = __builtin_amdgcn_ds_read_tr16_b64_v4i16((LAS s16x4*)vp), hi = __builtin_amdgcn_ds_read_tr16_b64_v4i16((LAS s16x4*)(vp + 8 * VSTR)); \
                bf16x8 vw; vw[0] = lo[0]; vw[1] = lo[1]; vw[2] = lo[2]; vw[3] = lo[3]; vw[4] = hi[0]; vw[5] = hi[1]; vw[6] = hi[2]; vw[7] = hi[3]; \
                o[dt] = MFMA32(vw, pf, o[dt]); } \
            __builtin_amdgcn_sched_barrier(0); } } while (0)
    constexpr int VBASE = RES ? 4 * KBYTES : 2 * KBYTES;
    if (!RES) { ATT_GLOAD(k_begin); ATT_LSTORE(0, 0); __syncthreads(); }
    int vcur = 0, vprev = 2;
    for (int t = 0; t < ntiles + (RES ? 0 : 1); ++t) {
        const int k0 = k_begin + 64 * t;
        if (!RES && t + 1 < ntiles) ATT_GLOAD(k0 + 64);
        if (late && pend) { ATT_PV(vprev); pend = false; }
        const bool vis = (t < ntiles) && (k0 <= qpos0 + 31) && (qpos0 - (k0 + 63) < window);
        if (vis) {
            const LAS unsigned char* Kt = lds + (RES ? t : (t & 1)) * KBYTES;
            f32x16 s0, s1;
#pragma unroll
            for (int j = 0; j < 16; ++j) { s0[j] = 0.f; s1[j] = 0.f; }
#pragma unroll
            for (int kk = 0; kk < KS; ++kk) {
                const bf16x8 a0 = *(const LAS bf16x8*)(Kt + c * KSTR + (16 * kk + 8 * h) * 2);
                const bf16x8 a1 = *(const LAS bf16x8*)(Kt + (32 + c) * KSTR + (16 * kk + 8 * h) * 2);
                s0 = MFMA32(a0, q[kk], s0); s1 = MFMA32(a1, q[kk], s1);
                if (kk & 1) __builtin_amdgcn_sched_barrier(0);
            }
            const bool full = (k0 + 63 <= qpos0) && (qpos0 + 31 - k0 < window);
            if (!full) {
                const int dbase = qpos0 + c - k0 - 4 * h;
#pragma unroll
                for (int j = 0; j < 16; ++j) { const int d0 = dbase - (8 * (j >> 2) + (j & 3)), d1 = d0 - 32;
                    if (d0 < 0 || d0 >= window) s0[j] = -INFINITY;
                    if (d1 < 0 || d1 >= window) s1[j] = -INFINITY; }
            }
            float tmax = fmaxf(s0[0], s1[0]);
#pragma unroll
            for (int j = 1; j < 16; ++j) tmax = fmaxf(tmax, fmaxf(s0[j], s1[j]));
            tmax = fmaxf(tmax, __shfl_xor(tmax, 32)) * scale2;
            const float mn = fmaxf(m, tmax); alpha = fexp2(m - mn); m = mn;
            float psum = 0.f;
#pragma unroll
            for (int j = 0; j < 16; ++j) { s0[j] = fexp2(__builtin_fmaf(s0[j], scale2, -mn)); s1[j] = fexp2(__builtin_fmaf(s1[j], scale2, -mn)); psum += s0[j] + s1[j]; }
            l = l * alpha + psum;
#pragma unroll
            for (int s = 0; s < 2; ++s) {
                pw[s].x = pk2(s0[8 * s + 0], s0[8 * s + 1]); pw[s].y = pk2(s0[8 * s + 2], s0[8 * s + 3]); pw[s].z = pk2(s0[8 * s + 4], s0[8 * s + 5]); pw[s].w = pk2(s0[8 * s + 6], s0[8 * s + 7]);
                pw[2 + s].x = pk2(s1[8 * s + 0], s1[8 * s + 1]); pw[2 + s].y = pk2(s1[8 * s + 2], s1[8 * s + 3]); pw[2 + s].z = pk2(s1[8 * s + 4], s1[8 * s + 5]); pw[2 + s].w = pk2(s1[8 * s + 6], s1[8 * s + 7]);
            }
            if (late) pend = true; else ATT_PV(vcur);
        }
        const int vnext = RES ? vcur + 1 : ((vcur == 2) ? 0 : vcur + 1);
        if (!RES && t + 1 < ntiles) ATT_LSTORE((t + 1) & 1, vnext);
        vprev = vcur; vcur = vnext;
        if (!RES) __syncthreads();
    }
    l += __shfl_xor(l, 32);
    const float inv = 1.0f / l;
#pragma unroll
    for (int dt = 0; dt < NDT; ++dt)
#pragma unroll
        for (int jq = 0; jq < 4; ++jq) {
            u32x2 w; w.x = pk2(o[dt][4 * jq] * inv, o[dt][4 * jq + 1] * inv); w.y = pk2(o[dt][4 * jq + 2] * inv, o[dt][4 * jq + 3] * inv);
            *(u32x2*)(Ow + (size_t)c * ldo + dt * 32 + 8 * jq + 4 * h) = w;
        }
#undef ATT_GLOAD
#undef ATT_LSTORE
#undef ATT_PV
}

DI int srccol(int mode, int n) {
    if (mode == 1) return n < 1280 ? ((n & ~63) + ((n & 63) >> 1) + 32 * (n & 1)) : n;
    if (mode == 2) { const int hh = n / 192, j = n % 192; if (j < 128) return n; const int jj = j - 128; return hh * 192 + 128 + (jj >> 1) + 32 * (jj & 1); }
    if (mode == 4) { const int ch = (n >> 8) * 128 + (n & 127); return ((n >> 7) & 1) ? 2816 + ch : ch; }
    if (mode == 3) { if (n < 640) return n; if (n < 704) { const int jj = n - 640; return 640 + (jj >> 1) + 32 * (jj & 1); } return -1; }
    return n;
}
DI void transpose_item(const float* src, int ldsrc, int K, int Nd, int mode, const float* gain, bf16_t* dst, LAS float* scr, int item, int lane) {
    const int nblk = Nd / 32, kb = item / nblk, nb = item % nblk, k0 = 64 * kb, n0 = 32 * nb;
    const int sc0 = srccol(mode, n0 + (lane & 31));
    const int sc = sc0 < 0 ? 0 : sc0; const float msk = sc0 < 0 ? 0.f : 1.f;
    if (mode == 0 || mode == 4) {
        const int scb = srccol(mode, n0) + (lane & 7) * 4;
#pragma unroll
        for (int i = 0; i < 8; ++i) { const int kk = (lane >> 3) + 8 * i; const f32x4 v = *(const f32x4*)(src + (size_t)(k0 + kk) * ldsrc + scb);
            LAS float* d = scr + kk * 33 + (lane & 7) * 4; d[0] = v.x; d[1] = v.y; d[2] = v.z; d[3] = v.w; }
    } else {
#pragma unroll 8
        for (int i = 0; i < 32; ++i) { const int kk = 2 * i + (lane >> 5); scr[kk * 33 + (lane & 31)] = src[(size_t)(k0 + kk) * ldsrc + sc] * msk; }
    }
    LDS_WAIT();
    const int c = lane & 7;
    f32x4 ga = {1.f, 1.f, 1.f, 1.f}, gb = ga;
    if (gain) { ga = *(const f32x4*)(gain + k0 + 8 * c); gb = *(const f32x4*)(gain + k0 + 8 * c + 4); }
#pragma unroll
    for (int j = 0; j < 4; ++j) { const int n = (lane >> 3) + 8 * j; const LAS float* s = scr + (8 * c) * 33 + n;
        u32x4 o; o.x = pk2(s[0 * 33] * ga.x, s[1 * 33] * ga.y); o.y = pk2(s[2 * 33] * ga.z, s[3 * 33] * ga.w); o.z = pk2(s[4 * 33] * gb.x, s[5 * 33] * gb.y); o.w = pk2(s[6 * 33] * gb.z, s[7 * 33] * gb.w);
        *(u32x4*)(dst + (size_t)(n0 + n) * K + k0 + 8 * c) = o; }
    LDS_WAIT();
}
DI void cvt_mat(int gw, int NGW, int lane, LAS float* scr, int& base, const float* src, int ldsrc, int K, int Nd, int mode, const float* gain, bf16_t* dst) {
    const int nitems = (K / 64) * (Nd / 32);
    for (int it = (gw + NGW - (base % NGW)) % NGW; it < nitems; it += NGW) transpose_item(src, ldsrc, K, Nd, mode, gain, dst, scr, it, lane);
    base += nitems;
}
DI void convert_set(const Ctx& cx, const Params& p, int set, LAS unsigned char* lds, int part) {
    const int wid = __builtin_amdgcn_readfirstlane(cx.tid >> 6), lane = cx.tid & 63;
    LAS float* scr = (LAS float*)(lds + wid * 8704);
    const int gw = cx.bid * 8 + wid, NGW = gridDim.x * 8;
    bf16_t* WB = (bf16_t*)(p.ws + WS_WB);
    int base = 0;
    if (set == 9) { cvt_mat(gw, NGW, lane, scr, base, p.in[20], 2048, 1024, 2048, 0, nullptr, (bf16_t*)(p.ws + WS_T)); return; }
    if (part == 1 && set >= 2) cvt_mat(gw, NGW, lane, scr, base, p.in[26] + (size_t)(set - 1) * 2816 * 1024, 1024, 2816, 1024, 0, nullptr, WB + OFF_FD);
    if (set >= 4) return;
    const int L = set, kind = L % 3, mj = L / 3;
    {
    { const f32x4* src4 = (const f32x4*)(p.in[21] + (size_t)L * 1048576); u32x2* dst2 = (u32x2*)(WB + OFF_XQ);
      for (int idx = cx.bid * 512 + cx.tid; idx < 262144; idx += gridDim.x * 512) { const f32x4 v = src4[idx]; u32x2 w; w.x = pk2(v.x, v.y); w.y = pk2(v.z, v.w); dst2[idx] = w; } }
    cvt_mat(gw, NGW, lane, scr, base, p.in[22] + (size_t)L * 1048576, 1024, 1024, 1024, 0, nullptr, WB + OFF_XO);
    cvt_mat(gw, NGW, lane, scr, base, p.in[23] + (size_t)L * 1024 * 5632, 5632, 1024, 5632, 4, nullptr, WB + OFF_FU);
    }
    if (part == 0) cvt_mat(gw, NGW, lane, scr, base, p.in[26] + (size_t)L * 2816 * 1024, 1024, 2816, 1024, 0, nullptr, WB + OFF_FD);
    if (kind == 0) {
        cvt_mat(gw, NGW, lane, scr, base, p.in[4] + (size_t)mj * 1048576, 1024, 1024, 1024, 0, nullptr, WB + OFF_MO);
        cvt_mat(gw, NGW, lane, scr, base, p.in[2] + (size_t)mj * 1024 * 1536, 1536, 1024, 1536, 1, nullptr, WB + OFF_M1);
    } else if (kind == 1) {
        cvt_mat(gw, NGW, lane, scr, base, p.in[13], 1024, 1024, 1024, 0, nullptr, WB + OFF_MO);
        cvt_mat(gw, NGW, lane, scr, base, p.in[5], 2048, 1024, 2048, 0, nullptr, WB + OFF_M1);
#pragma unroll 1
        for (int hh = 0; hh < 4; ++hh) {
            cvt_mat(gw, NGW, lane, scr, base, p.in[8] + (size_t)hh * 65536, 256, 256, 256, 0, nullptr, WB + OFF_M2 + (size_t)(hh * 512) * 256);
            cvt_mat(gw, NGW, lane, scr, base, p.in[10] + (size_t)hh * 65536, 256, 256, 256, 0, nullptr, WB + OFF_M2 + (size_t)(hh * 512 + 256) * 256);
        }
    } else {
        cvt_mat(gw, NGW, lane, scr, base, p.in[19], 1024, 1024, 1024, 0, nullptr, WB + OFF_MO);
        cvt_mat(gw, NGW, lane, scr, base, p.in[14], 704, 1024, 768, 3, nullptr, WB + OFF_M1);
        cvt_mat(gw, NGW, lane, scr, base, p.in[17], 1536, 384, 1536, 2, p.in[15], WB + OFF_M2);
        cvt_mat(gw, NGW, lane, scr, base, p.in[18], 2048, 256, 2048, 0, p.in[16], WB + OFF_M3);
    }
}

DI void setup_phase(const Ctx& cx, const Params& p, LAS unsigned char* lds) {
    const size_t gt = (size_t)cx.bid * 512 + cx.tid, NT = (size_t)gridDim.x * 512;
    float* cosT = (float*)(p.ws + WS_MISC + MS_COS); float* sinT = (float*)(p.ws + WS_MISC + MS_SIN);
    for (size_t idx = gt; idx < (size_t)SEQ * 32; idx += NT) {
        const int pos = (int)(idx >> 5), i = (int)(idx & 31);
        double r = 1.0; for (int k = 0; k < i; ++k) r *= 0.7498942093324559;
        const float inv = (float)r; const float ang = (float)pos * inv;
        const double a = (double)ang * 0.15915494309189535; const double fr = a - __builtin_rint(a);
        const float f = (float)fr;
        cosT[idx] = __builtin_amdgcn_cosf(f); sinT[idx] = __builtin_amdgcn_sinf(f);
    }
    const f32x4* x4 = (const f32x4*)p.in[0]; u32x2* xb = (u32x2*)(p.ws + WS_XB);
    for (size_t idx = gt; idx < (size_t)MTOK * 256; idx += NT) { const f32x4 v = x4[idx]; u32x2 w; w.x = pk2(v.x, v.y); w.y = pk2(v.z, v.w); xb[idx] = w; }
    const f32x4* m4 = (const f32x4*)p.in[1]; u32x2* mb = (u32x2*)(p.ws + WS_MISC + MS_MEMB);
    for (size_t idx = gt; idx < (size_t)1024 * 256; idx += NT) { const f32x4 v = m4[idx]; u32x2 w; w.x = pk2(v.x, v.y); w.y = pk2(v.z, v.w); mb[idx] = w; }
    convert_set(cx, p, 9, lds, 0);
    convert_set(cx, p, 0, lds, 0);
}

DI void ln_phase(const Ctx& cx, const Params& p, int lnidx) {
    const float* g = p.in[27] + lnidx * 1024; const float* b = p.in[28] + lnidx * 1024;
    float* X = p.out; bf16_t* XB = (bf16_t*)(p.ws + WS_XB); f32x2* ST = (f32x2*)(p.ws + WS_MISC + MS_SP);
    const bool final_ln = (lnidx == 11);
    const int wid = __builtin_amdgcn_readfirstlane(cx.tid >> 6), lane = cx.tid & 63, gw = cx.bid * 8 + wid, NGW = gridDim.x * 8;
    f32x4 gv[4], bv[4];
#pragma unroll
    for (int j = 0; j < 4; ++j) { gv[j] = *(const f32x4*)(g + 4 * lane + 256 * j); bv[j] = *(const f32x4*)(b + 4 * lane + 256 * j); }
    for (int row = gw; row < MTOK; row += NGW) {
        f32x4* xr = (f32x4*)(X + (size_t)row * 1024) + lane; f32x4 v[4]; float s = 0.f;
#pragma unroll
        for (int j = 0; j < 4; ++j) { v[j] = xr[64 * j]; s += (v[j].x + v[j].y) + (v[j].z + v[j].w); }
        const float mean = wave_sum(s) * (1.f / 1024.f); float s2 = 0.f;
#pragma unroll
        for (int j = 0; j < 4; ++j) { v[j] = v[j] - mean; s2 += (v[j].x * v[j].x + v[j].y * v[j].y) + (v[j].z * v[j].z + v[j].w * v[j].w); }
        const float rstd = 1.f / sqrtf(wave_sum(s2) * (1.f / 1024.f) + 1e-5f);
        if (lane == 0) ST[row] = (f32x2){mean, rstd};
        u32x2* ob = (u32x2*)(XB + (size_t)row * 1024) + lane;
#pragma unroll
        for (int j = 0; j < 4; ++j) { const f32x4 y = v[j] * rstd * gv[j] + bv[j]; if (final_ln) xr[64 * j] = y; u32x2 w; w.x = pk2(y.x, y.y); w.y = pk2(y.z, y.w); ob[64 * j] = w; }
    }
}

DI void lruconv_phase(const Ctx& cx, const Params& p) {
    const bf16_t* P = (const bf16_t*)(p.ws + WS_T); bf16_t* U = (bf16_t*)(p.ws + WS_T + 128 * MiB);
    const float* cw = p.in[6]; const float* cb = p.in[7];
    const int wid = cx.tid >> 6, lane = cx.tid & 63, gw = cx.bid * 8 + wid, NGW = gridDim.x * 8;
    for (int item = gw; item < 2048; item += NGW) {
        const int rb = item >> 1, c0 = (item & 1) * 512 + lane * 8, row0 = rb * 32;
        const V8 w0 = ldf8(cw + c0), w1 = ldf8(cw + 1024 + c0), w2 = ldf8(cw + 2048 + c0), w3 = ldf8(cw + 3072 + c0), bb = ldf8(cb + c0);
        V8 h3, h2, h1; const f32x4 z = {0.f, 0.f, 0.f, 0.f}; h3.a = z; h3.b = z; h2 = h3; h1 = h3;
        const bf16_t* src = P + (size_t)row0 * 2048 + 1024 + c0;
        if ((row0 & (SEQ - 1)) != 0) { h3 = unpack8(*(const u32x4*)(src - 3 * 2048)); h2 = unpack8(*(const u32x4*)(src - 2 * 2048)); h1 = unpack8(*(const u32x4*)(src - 2048)); }
#pragma unroll 4
        for (int r = 0; r < 32; ++r) {
            const V8 cur = unpack8(*(const u32x4*)(src + (size_t)r * 2048));
            V8 y; y.a = bb.a + w0.a * h3.a + w1.a * h2.a + w2.a * h1.a + w3.a * cur.a; y.b = bb.b + w0.b * h3.b + w1.b * h2.b + w2.b * h1.b + w3.b * cur.b;
            *(u32x4*)(U + (size_t)(row0 + r) * 1024 + c0) = pack8(y);
            h3 = h2; h2 = h1; h1 = cur;
        }
    }
}

DI float neg_expm1(float x) {
    if (x > -0.125f) return -x * (1.f + x * (0.5f + x * (0.16666667f + x * (0.041666668f + x * (0.0083333338f + x * 0.0013888889f)))));
    return 1.f - fexp(x);
}
DI float gelu_tanh(float g) { const float z2 = 1.5957691216057308f * (g + 0.044715f * g * g * g); return g * __builtin_amdgcn_rcpf(1.f + fexp(-z2)); }

constexpr int SCH = 32, NCHK = SEQ / SCH;
template <int PASS>
DI void scan_phase(const Ctx& cx, const Params& p) {
    const bf16_t* P = (const bf16_t*)(p.ws + WS_T); const bf16_t* U = (const bf16_t*)(p.ws + WS_T + 128 * MiB);
    const bf16_t* G = (const bf16_t*)(p.ws + WS_T + 192 * MiB); bf16_t* YB = (bf16_t*)(p.ws + WS_T) + 1024;
    float* SP = (float*)(p.ws + WS_T + 320 * MiB); float* SH = (float*)(p.ws + WS_T + 324 * MiB); float* CR = (float*)(p.ws + WS_T + 328 * MiB);
    const float* lam = p.in[12];
    const int wid = __builtin_amdgcn_readfirstlane(cx.tid >> 6), lane = cx.tid & 63, gw = cx.bid * 8 + wid, NGW = gridDim.x * 8;
    for (int item = gw; item < 4 * NCHK * 4; item += NGW) {
        const int hq = item & 3, chunk = (item >> 2) % NCHK, b = item / (4 * NCHK);
        const int c0 = hq * 256 + lane * 4;
        f32x4 spc;
        { const f32x4 lm = *(const f32x4*)(lam + c0);
#pragma unroll
          for (int e = 0; e < 4; ++e) { const float z = -lm[e]; spc[e] = 8.0f * (fmaxf(z, 0.f) + log1pf(fexp(-fabsf(z)))); } }
        const size_t so = (size_t)(b * NCHK + chunk) * 1024 + c0;
        f32x4 hh = {0.f, 0.f, 0.f, 0.f}, pp = {1.f, 1.f, 1.f, 1.f};
        if (PASS == 2) hh = *(const f32x4*)(CR + so);
        const size_t row0 = (size_t)b * SEQ + chunk * SCH;
#pragma unroll 1
        for (int t0 = 0; t0 < SCH; t0 += 8) {
            u32x2 rw[8], iw[8], uw[8], gw2[8];
#pragma unroll
            for (int t = 0; t < 8; ++t) { const size_t row = row0 + t0 + t;
                rw[t] = *(const u32x2*)(G + row * 2048 + hq * 512 + lane * 4); iw[t] = *(const u32x2*)(G + row * 2048 + hq * 512 + 256 + lane * 4);
                uw[t] = *(const u32x2*)(U + row * 1024 + c0); if (PASS == 2) gw2[t] = *(const u32x2*)(P + row * 2048 + c0); }
#pragma unroll
            for (int t = 0; t < 8; ++t) {
                const f32x4 r = {bf_lo(rw[t].x), bf_hi(rw[t].x), bf_lo(rw[t].y), bf_hi(rw[t].y)}, ig = {bf_lo(iw[t].x), bf_hi(iw[t].x), bf_lo(iw[t].y), bf_hi(iw[t].y)}, uu = {bf_lo(uw[t].x), bf_hi(uw[t].x), bf_lo(uw[t].y), bf_hi(uw[t].y)};
                f32x4 a, bi;
#pragma unroll
                for (int e = 0; e < 4; ++e) { const float la = -spc[e] * r[e]; a[e] = fexp(la); bi[e] = sqrtf(fmaxf(neg_expm1(2.f * la), 0.f)) * (ig[e] * uu[e]); }
                hh = a * hh + bi;
                if (PASS == 1) pp *= a;
                else {
                    const f32x4 gt = {bf_lo(gw2[t].x), bf_hi(gw2[t].x), bf_lo(gw2[t].y), bf_hi(gw2[t].y)};
                    u32x2 w; w.x = pk2(hh.x * gelu_tanh(gt.x), hh.y * gelu_tanh(gt.y)); w.y = pk2(hh.z * gelu_tanh(gt.z), hh.w * gelu_tanh(gt.w));
                    *(u32x2*)(YB + (row0 + t0 + t) * 2048 + c0) = w;
                }
            }
        }
        if (PASS == 1) { *(f32x4*)(SP + so) = pp; *(f32x4*)(SH + so) = hh; }
    }
}
DI void scanmid_phase(const Ctx& cx, const Params& p, LAS unsigned char* lds) {
    if (cx.bid >= 32) return;
    const float* SP = (const float*)(p.ws + WS_T + 320 * MiB); const float* SH = (const float*)(p.ws + WS_T + 324 * MiB); float* CR = (float*)(p.ws + WS_T + 328 * MiB);
    const int b = cx.bid >> 3, cq = cx.tid & 31, seg = cx.tid >> 5, c0 = ((cx.bid & 7) * 32 + cq) * 4;
    LAS f32x4* L = (LAS f32x4*)lds;
    f32x4 A = {1.f, 1.f, 1.f, 1.f}, H = {0.f, 0.f, 0.f, 0.f};
    f32x4 a[16], h0[16];
#pragma unroll
    for (int k = 0; k < 16; ++k) { const size_t o = (size_t)(b * NCHK + seg * 16 + k) * 1024 + c0; a[k] = *(const f32x4*)(SP + o); h0[k] = *(const f32x4*)(SH + o); }
#pragma unroll
    for (int k = 0; k < 16; ++k) { H = a[k] * H + h0[k]; A *= a[k]; }
    L[(cq * 16 + seg) * 2] = A; L[(cq * 16 + seg) * 2 + 1] = H;
    __syncthreads();
    f32x4 hc = {0.f, 0.f, 0.f, 0.f};
    for (int s2 = 0; s2 < seg; ++s2) { const f32x4 As = L[(cq * 16 + s2) * 2], Hs = L[(cq * 16 + s2) * 2 + 1]; hc = As * hc + Hs; }
#pragma unroll
    for (int k = 0; k < 16; ++k) { *(f32x4*)(CR + (size_t)(b * NCHK + seg * 16 + k) * 1024 + c0) = hc; hc = a[k] * hc + h0[k]; }
    __syncthreads();
}

DI void glufix_phase(const Ctx& cx, const Params& p, int layer) {
    bf16_t* ACT = (bf16_t*)(p.ws + WS_T); const bf16_t* HF = (const bf16_t*)(p.ws + WS_T + 176 * MiB); const bf16_t* HL = (const bf16_t*)(p.ws + WS_T + 188 * MiB);
    const float* cw = p.in[24] + (size_t)layer * 3 * 5632; const float* cb = p.in[25] + (size_t)layer * 5632;
    const int total = 512 * 2 * 352;
    for (int idx = cx.bid * 512 + cx.tid; idx < total; idx += gridDim.x * 512) {
        const int c = idx % 352, r = (idx / 352) & 1, blk = idx / 704, col = c * 8, row = blk * 64 + r;
        const bool hasprev = ((blk * 64) & (SEQ - 1)) != 0;
        const u32x4 zz = {0u, 0u, 0u, 0u};
        u32x4 g0r = zz, g1r = zz, u0r = zz, u1r = zz;
        const bf16_t* hf = HF + (size_t)(blk * 2) * 5632 + col;
        if (r == 1) { g1r = *(const u32x4*)hf; u1r = *(const u32x4*)(hf + 2816); }
        if (hasprev) {
            const bf16_t* hl = HL + (size_t)((blk - 1) * 2) * 5632 + col;
            if (r == 1) { g0r = *(const u32x4*)(hl + 5632); u0r = *(const u32x4*)(hl + 5632 + 2816); }
            else { g0r = *(const u32x4*)hl; u0r = *(const u32x4*)(hl + 2816); g1r = *(const u32x4*)(hl + 5632); u1r = *(const u32x4*)(hl + 5632 + 2816); }
        }
        const u32x4 gcr = *(const u32x4*)(hf + (size_t)r * 5632), ucr = *(const u32x4*)(hf + (size_t)r * 5632 + 2816);
        const V8 g0 = ldf8(cw + col), g1 = ldf8(cw + 5632 + col), g2 = ldf8(cw + 2 * 5632 + col), gb = ldf8(cb + col);
        const V8 u0 = ldf8(cw + 2816 + col), u1 = ldf8(cw + 5632 + 2816 + col), u2 = ldf8(cw + 2 * 5632 + 2816 + col), ub = ldf8(cb + 2816 + col);
        const V8 gh2 = unpack8(g0r), gh1 = unpack8(g1r), gc = unpack8(gcr), uh2 = unpack8(u0r), uh1 = unpack8(u1r), uc = unpack8(ucr);
        V8 gv, uv, o;
        gv.a = gb.a + g0.a * gh2.a + g1.a * gh1.a + g2.a * gc.a; gv.b = gb.b + g0.b * gh2.b + g1.b * gh1.b + g2.b * gc.b;
        uv.a = ub.a + u0.a * uh2.a + u1.a * uh1.a + u2.a * uc.a; uv.b = ub.b + u0.b * uh2.b + u1.b * uh1.b + u2.b * uc.b;
#pragma unroll
        for (int e = 0; e < 4; ++e) { o.a[e] = gv.a[e] * __builtin_amdgcn_rcpf(1.f + fexp(-gv.a[e])) * uv.a[e]; o.b[e] = gv.b[e] * __builtin_amdgcn_rcpf(1.f + fexp(-gv.b[e])) * uv.b[e]; }
        *(u32x4*)(ACT + (size_t)row * 2816 + col) = pack8(o);
    }
}

DI void mlaprep_phase(const Ctx& cx, const Params& p) {
    const bf16_t* Cc = (const bf16_t*)(p.ws + WS_T); bf16_t* KR = (bf16_t*)(p.ws + WS_T + 272 * MiB);
    float* rsq = (float*)(p.ws + WS_MISC + MS_RSQ); float* rskv = (float*)(p.ws + WS_MISC + MS_RSKV);
    const float* cosT = (const float*)(p.ws + WS_MISC + MS_COS); const float* sinT = (const float*)(p.ws + WS_MISC + MS_SIN);
    const int wid = cx.tid >> 6, lane = cx.tid & 63, gw = cx.bid * 8 + wid, NGW = gridDim.x * 8;
    for (int row = gw; row < MTOK; row += NGW) {
        const bf16_t* src = Cc + (size_t)row * 768;
        const V8 v0 = unpack8(*(const u32x4*)(src + 8 * lane));
        const float ss0 = ((v0.a.x * v0.a.x + v0.a.y * v0.a.y) + (v0.a.z * v0.a.z + v0.a.w * v0.a.w)) + ((v0.b.x * v0.b.x + v0.b.y * v0.b.y) + (v0.b.z * v0.b.z + v0.b.w * v0.b.w));
        float sq = (lane < 48) ? ss0 : 0.f, skv = (lane < 48) ? 0.f : ss0;
        if (lane < 32) {
            const V8 v1 = unpack8(*(const u32x4*)(src + 512 + 8 * lane));
            if (lane < 16) skv += ((v1.a.x * v1.a.x + v1.a.y * v1.a.y) + (v1.a.z * v1.a.z + v1.a.w * v1.a.w)) + ((v1.b.x * v1.b.x + v1.b.y * v1.b.y) + (v1.b.z * v1.b.z + v1.b.w * v1.b.w));
            else if (lane < 24) {
                const int pos = row & (SEQ - 1), f0 = 4 * (lane - 16);
                const f32x4 cs = *(const f32x4*)(cosT + pos * 32 + f0), sn = *(const f32x4*)(sinT + pos * 32 + f0);
                V8 r;
                r.a.x = v1.a.x * cs.x - v1.a.y * sn.x; r.a.y = v1.a.y * cs.x + v1.a.x * sn.x;
                r.a.z = v1.a.z * cs.y - v1.a.w * sn.y; r.a.w = v1.a.w * cs.y + v1.a.z * sn.y;
                r.b.x = v1.b.x * cs.z - v1.b.y * sn.z; r.b.y = v1.b.y * cs.z + v1.b.x * sn.z;
                r.b.z = v1.b.z * cs.w - v1.b.w * sn.w; r.b.w = v1.b.w * cs.w + v1.b.z * sn.w;
                *(u32x4*)(KR + (size_t)row * 64 + 8 * (lane - 16)) = pack8(r);
            }
        }
        sq = wave_sum(sq); skv = wave_sum(skv);
        if (lane == 0) { rsq[row] = 1.f / sqrtf(sq * (1.f / 384.f) + 1e-6f); rskv[row] = 1.f / sqrtf(skv * (1.f / 256.f) + 1e-6f); }
    }
}

DI void swa_phase(const Ctx& cx, const Params& p, int mj, LAS unsigned char* lds) {
    const bf16_t* QKV = (const bf16_t*)(p.ws + WS_T); bf16_t* AO = (bf16_t*)(p.ws + WS_T + 96 * MiB);
    const float* sinks = p.in[3] + mj * 16;
    const int tid = cx.tid, wid = __builtin_amdgcn_readfirstlane(tid >> 6);
    constexpr int KSTR = 144, KBYTES = 64 * KSTR, VSTR = 192, VBYTES = 64 * VSTR;
    for (int item = cx.bid; item < 1024; item += gridDim.x) {
        const int n = item & 63, kvh = (item >> 6) & 3, b = item >> 8;
        const size_t rowbase = (size_t)b * SEQ;
        const bf16_t* Kb = QKV + rowbase * 1536 + 1024 + kvh * 64; const bf16_t* Vb = QKV + rowbase * 1536 + 1280 + kvh * 64;
        const int k_begin = (n > 0 ? n - 1 : 0) * 128, k_end = (n + 1) * 128, nkeys = k_end - k_begin;
        u32x4 kr[4], vr[4];
#pragma unroll
        for (int i = 0; i < 4; ++i) { const int ci = tid + 512 * i, key = ci >> 3, part = ci & 7;
            if (key < nkeys) { kr[i] = *(const u32x4*)(Kb + (size_t)(k_begin + key) * 1536 + part * 8); vr[i] = *(const u32x4*)(Vb + (size_t)(k_begin + key) * 1536 + part * 8); } }
#pragma unroll
        for (int i = 0; i < 4; ++i) { const int ci = tid + 512 * i, key = ci >> 3, part = ci & 7;
            if (key < nkeys) { *(LAS u32x4*)(lds + (key >> 6) * KBYTES + (key & 63) * KSTR + part * 16) = kr[i]; *(LAS u32x4*)(lds + 4 * KBYTES + (key >> 6) * VBYTES + (key & 63) * VSTR + part * 16) = vr[i]; } }
        __syncthreads();
        const int qpos0 = n * 128 + (wid & 3) * 32;
#pragma unroll 1
        for (int half = 0; half < 2; ++half) {
            const int head = kvh * 4 + half * 2 + (wid >> 2);
            attn_block<64, 0, 64, true>(cx, lds, QKV + (rowbase + qpos0) * 1536 + head * 64, 1536, Kb, 1536, Kb, 1536, Vb, 1536, k_begin, k_end, qpos0, 128, 0.125f * LOG2E, sinks[head] * LOG2E, 1.0f,
                                        AO + (rowbase + qpos0) * 1024 + head * 64, 1024);
        }
        __syncthreads();
    }
}
DI void mla_phase(const Ctx& cx, const Params& p, LAS unsigned char* lds) {
    const bf16_t* Qm = (const bf16_t*)(p.ws + WS_T + 48 * MiB); const bf16_t* KV = (const bf16_t*)(p.ws + WS_T + 144 * MiB);
    const bf16_t* KR = (const bf16_t*)(p.ws + WS_T + 272 * MiB); bf16_t* AO = (bf16_t*)(p.ws + WS_T + 276 * MiB);
    const int wid = __builtin_amdgcn_readfirstlane(cx.tid >> 6);
    for (int pid0 = cx.bid; pid0 < 512; pid0 += gridDim.x) {
        const int pid = (gridDim.x == 256) ? ((pid0 & ~255) + (pid0 & 7) * 32 + ((pid0 & 255) >> 3)) : pid0;
        const int bh = pid >> 4, qa = pid & 15, b = bh >> 3, hd = bh & 7;
        const size_t rowbase = (size_t)b * SEQ;
#pragma unroll 1
        for (int sub = 0; sub < 2; ++sub) {
            const int qt = sub ? 31 - qa : qa, qpos0 = qt * 256 + wid * 32;
            attn_block<128, 64, 128>(cx, lds, Qm + (rowbase + qpos0) * 1536 + hd * 192, 1536, KV + rowbase * 2048 + hd * 256, 2048, KR + rowbase * 64, 64,
                                     KV + rowbase * 2048 + hd * 256 + 128, 2048, 0, (qt + 1) * 256, qpos0, 0x40000000, 0.07216878364870322f * LOG2E, -1e30f, 0.f,
                                     AO + (rowbase + qpos0) * 1024 + hd * 128, 1024);
        }
    }
}


#define XB_TMO      128
#define XB_XCNT(j)  (256  + 64 * (j))
#define XB_XSUB(j)  (1280 + 64 * (j))
#define XB_XGEN(j)  (2304 + 64 * (j))
#define XB_TOP      3328
#define XB_TOPGEN   3392
#define XCD_BAR_WORDS 3456
#define XB_SPIN_CAP (1u << 18)
DI unsigned xb_ld(unsigned* p)              { return __hip_atomic_load(p, __ATOMIC_RELAXED, __HIP_MEMORY_SCOPE_AGENT); }
DI unsigned xb_add(unsigned* p, unsigned v) { return __hip_atomic_fetch_add(p, v, __ATOMIC_RELAXED, __HIP_MEMORY_SCOPE_AGENT); }
DI unsigned xb_xcc_id() { return (unsigned)__builtin_amdgcn_s_getreg((3 << 11) | 20) & 0xFu; }
#define XB_SPIN(cond, bar) do { unsigned _sp = 0; while (cond) { __builtin_amdgcn_s_sleep(1); \
    if ((++_sp & 255u) == 0u) { if (xb_ld(&(bar)[XB_TMO])) break; if (_sp > XB_SPIN_CAP) { atomicAdd(&(bar)[XB_TMO], 1u); break; } } } } while (0)
struct XcdBarrier { unsigned* bar; unsigned x; volatile LAS unsigned* st; };
DI XcdBarrier xcd_barrier_post(unsigned* bar, volatile LAS unsigned* st) {
    XcdBarrier b; b.bar = bar; b.x = xb_xcc_id(); b.st = st;
    if (threadIdx.x == 0) (void)xb_add(&bar[XB_XCNT(b.x)], 1u);
    return b;
}
DI void xcd_barrier_complete(unsigned* bar, unsigned x, unsigned& nloc, unsigned& nx) {
    const unsigned G = gridDim.x * gridDim.y * gridDim.z;
    unsigned sum, cnt, mine, sp = 0u;
    for (;;) {
        sum = 0u; cnt = 0u; mine = 0u;
#pragma unroll
        for (unsigned j = 0; j < 16; ++j) { const unsigned c = xb_ld(&bar[XB_XCNT(j)]); sum += c; cnt += (c > 0u) ? 1u : 0u; mine = (j == x) ? c : mine; }
        if (sum == G) break;
        __builtin_amdgcn_s_sleep(1);
        if ((++sp & 255u) == 0u) { if (xb_ld(&bar[XB_TMO])) break; if (sp > XB_SPIN_CAP) { atomicAdd(&bar[XB_TMO], 1u); break; } }
    }
    nloc = mine > 0u ? mine : 1u; nx = cnt > 0u ? cnt : 1u;
}
DI void xcd_barrier(const XcdBarrier& b) {
    asm volatile("s_waitcnt vmcnt(0)" ::: "memory");
    __syncthreads();
    if (threadIdx.x == 0) {
        unsigned* bar = b.bar;
        __builtin_amdgcn_s_waitcnt(0);
        unsigned nloc = b.st[0], nx = b.st[1];
        if (nloc == 0u) { xcd_barrier_complete(bar, b.x, nloc, nx); b.st[0] = nloc; b.st[1] = nx; }
        const unsigned old = xb_add(&bar[XB_XSUB(b.x)], 1u);
        const unsigned gen = old / nloc;
        if (old + 1u == (gen + 1u) * nloc) {
            __builtin_amdgcn_fence(__ATOMIC_RELEASE, "agent");
            asm volatile("s_waitcnt vmcnt(0)" ::: "memory");
            const unsigned og = xb_add(&bar[XB_TOP], 1u);
            const unsigned tg = og / nx;
            if (og + 1u == (tg + 1u) * nx) xb_add(&bar[XB_TOPGEN], 1u);
            else XB_SPIN(xb_ld(&bar[XB_TOPGEN]) == tg, bar);
            __builtin_amdgcn_fence(__ATOMIC_ACQUIRE, "agent");
            xb_add(&bar[XB_XGEN(b.x)], 1u);
            asm volatile("s_waitcnt vmcnt(0)" ::: "memory");
        } else {
            XB_SPIN(xb_ld(&bar[XB_XGEN(b.x)]) == gen, bar);
            __builtin_amdgcn_fence(__ATOMIC_ACQUIRE, "agent");
            asm volatile("s_waitcnt vmcnt(0)" ::: "memory");
        }
    }
    __syncthreads();
}

enum { K_SETUP = 0, K_GEMM, K_SWA, K_MLA, K_LN, K_LRUCONV, K_SCAN1, K_SCAN2, K_GLU, K_MLAPREP, K_DUMP, K_SCANMID };
struct PhaseD { int kind, nosync, layer, arg; GemmD g; };

DI void gd_init(GemmD& g, const void* A, int lda, const void* Bt, int ldb, int M, int N, int K, int epi, void* C, int ldc) {
    g.A = (const bf16_t*)A; g.Bt = (const bf16_t*)Bt; g.lda = lda; g.ldb = ldb; g.M = M; g.N = N; g.K = K; g.G = 1;
    g.sA1 = g.sA2 = g.sB1 = g.sB2 = g.sC1 = g.sC2 = 0; g.epi = epi; g.opt = ROPE_NONE; g.ldc = ldc; g.growstep = 0; g.gshift = 2; g.rot = 0; g.C = C; g.aux0 = nullptr; g.aux1 = nullptr; g.scale = 1.f;
}
#define RES_PREV(sidx) do { const int s_ = (sidx); if (s_ == 0) d.g.aux1 = p.in[0]; d.g.aux0 = (const float*)(MS + MS_SP); d.g.opt = 32 * (s_ + 1); d.g.cosT = p.in[27] + s_ * 1024; d.g.sinT = p.in[28] + s_ * 1024; } while (0)
DI void make_desc(const Params& p, int ph, PhaseD& d) {
    unsigned char* ws = p.ws; unsigned char* T = ws + WS_T; unsigned char* MS = ws + WS_MISC;
    bf16_t* WB = (bf16_t*)(ws + WS_WB); bf16_t* XB = (bf16_t*)(ws + WS_XB);
    d.kind = K_SETUP; d.nosync = 0; d.layer = 0; d.arg = 0;
    gd_init(d.g, XB, 1024, WB, 1024, MTOK, 1024, 1024, EPI_BF16, T, 1024);
    d.g.cosT = (const float*)(MS + MS_COS); d.g.sinT = (const float*)(MS + MS_SIN);
    if (ph == 0) return;
    if (ph == 1) { d.kind = K_GEMM; gd_init(d.g, MS + MS_MEMB, 1024, T, 1024, 1024, 1024, 1024, EPI_BF16, MS + MS_KMEM, 1024); return; }
    if (ph == 2) { d.kind = K_GEMM; d.nosync = 1; gd_init(d.g, MS + MS_MEMB, 1024, T + 2 * MiB, 1024, 1024, 1024, 1024, EPI_BF16, MS + MS_VT, 1024); d.g.rot = 16; return; }
    int q = ph - 3, layer = 0;
    for (;;) { const int k3 = layer % 3, cnt = (k3 == 0 ? 5 : (k3 == 1 ? 9 : 8)) + 5; if (q < cnt) break; q -= cnt; ++layer; }
    const int kind = layer % 3, nm = (kind == 0 ? 5 : (kind == 1 ? 9 : 8));
    d.layer = layer;
    if (q == 1) {
        d.kind = K_GEMM; d.nosync = 1; gd_init(d.g, MS + MS_KMEM, 1024, WB + OFF_XQ, 1024, 256, 1024, 256, EPI_BF16, T + 384 * MiB, 1024);
        d.g.G = 16; d.g.sA1 = 256 * 1024; d.g.sA2 = 256; d.g.sB1 = 0; d.g.sB2 = 256; d.g.sC1 = 1024 * 1024; d.g.sC2 = 256 * 1024; d.g.rot = 192; return; }
    if (q == 2) {
        d.kind = K_GEMM; d.nosync = 1; gd_init(d.g, WB + OFF_XO, 1024, MS + MS_VT, 1024, 1024, 256, 256, EPI_BF16, T + 392 * MiB, 1024);
        d.g.G = 16; d.g.sA1 = 0; d.g.sA2 = 256; d.g.sB1 = 256 * 1024; d.g.sB2 = 256; d.g.sC1 = 1024 * 1024; d.g.sC2 = 256; d.g.rot = 128; return; }
    if (q < nm) {
        if (q > 2) q -= 2;
        if (kind == 0) {
            if (q == 0) { d.kind = K_GEMM; gd_init(d.g, XB, 1024, WB + OFF_M1, 1024, MTOK, 1536, 1024, EPI_BF16, T, 1536); d.g.opt = ROPE_SWA; }
            else if (q == 1) { d.kind = K_SWA; }
            else if (q == 2) { d.kind = K_GEMM; gd_init(d.g, T + 96 * MiB, 1024, WB + OFF_MO, 1024, MTOK, 1024, 1024, EPI_RES, p.out, 1024); RES_PREV(layer * 3 + 0); }
            else { d.kind = K_LN; d.arg = layer * 3 + 0; }
        } else if (kind == 1) {
            if (q == 0) { d.kind = K_GEMM; gd_init(d.g, XB, 1024, WB + OFF_M1, 1024, MTOK, 2048, 1024, EPI_BF16, T, 2048); }
            else if (q == 1) { d.kind = K_LRUCONV; }
            else if (q == 2) { d.kind = K_GEMM; gd_init(d.g, T + 128 * MiB, 1024, WB + OFF_M2, 256, MTOK, 512, 256, EPI_SIG, T + 192 * MiB, 2048);
                               d.g.G = 4; d.g.sA2 = 256; d.g.sB2 = 512 * 256; d.g.sC2 = 512; d.g.aux0 = p.in[9]; d.g.aux1 = p.in[11]; }
            else if (q == 3) { d.kind = K_SCAN1; }
            else if (q == 4) { d.kind = K_SCANMID; }
            else if (q == 5) { d.kind = K_SCAN2; }
            else if (q == 6) { d.kind = K_GEMM; gd_init(d.g, (bf16_t*)T + 1024, 2048, WB + OFF_MO, 1024, MTOK, 1024, 1024, EPI_RES, p.out, 1024); RES_PREV(layer * 3 + 0); }
            else { d.kind = K_LN; d.arg = layer * 3 + 0; }
        } else {
            if (q == 0) { d.kind = K_GEMM; gd_init(d.g, XB, 1024, WB + OFF_M1, 1024, MTOK, 768, 1024, EPI_BF16, T, 768); }
            else if (q == 1) { d.kind = K_MLAPREP; }
            else if (q == 2) { d.kind = K_GEMM; gd_init(d.g, T, 768, WB + OFF_M2, 384, MTOK, 1536, 384, EPI_BF16, T + 48 * MiB, 1536); d.g.opt = ROPE_MLAQ; d.g.aux0 = (const float*)(MS + MS_RSQ); }
            else if (q == 3) { d.kind = K_GEMM; d.nosync = 1; gd_init(d.g, (bf16_t*)T + 384, 768, WB + OFF_M3, 256, MTOK, 2048, 256, EPI_BF16, T + 144 * MiB, 2048); d.g.aux0 = (const float*)(MS + MS_RSKV); }
            else if (q == 4) { d.kind = K_MLA; }
            else if (q == 5) { d.kind = K_GEMM; gd_init(d.g, T + 276 * MiB, 1024, WB + OFF_MO, 1024, MTOK, 1024, 1024, EPI_RES, p.out, 1024); RES_PREV(layer * 3 + 0); }
            else { d.kind = K_LN; d.arg = layer * 3 + 0; }
        }
        return;
    }
    q -= nm;
    if (q < 2) {
        if (q == 0) { d.kind = K_GEMM; gd_init(d.g, XB, 1024, T + 384 * MiB, 1024, SEQ, 1024, 1024, EPI_EXPN, T, 1024);
                      d.g.G = 4; d.g.gshift = 0; d.g.sA1 = (long)SEQ * 1024; d.g.sB1 = 1024 * 1024; d.g.sC1 = (long)SEQ * 1024; d.g.growstep = SEQ; d.g.scale = 0.0625f; }
        else if (q == 1) { d.kind = K_GEMM; gd_init(d.g, T, 1024, T + 392 * MiB, 1024, SEQ, 1024, 1024, EPI_RES, p.out, 1024);
                           d.g.G = 4; d.g.gshift = 0; d.g.sA1 = (long)SEQ * 1024; d.g.sB1 = 1024 * 1024; d.g.growstep = SEQ; RES_PREV(layer * 3 + 1); }
        return;
    }
    q -= 2;
    if (q == 0) { d.kind = K_GEMM; gd_init(d.g, XB, 1024, WB + OFF_FU, 1024, MTOK, 5632, 1024, EPI_GLU, T, 2816);
                  d.g.aux0 = p.in[24] + (size_t)layer * 3 * 5632; d.g.aux1 = p.in[25] + (size_t)layer * 5632; d.g.cosT = (const float*)(T + 176 * MiB); d.g.sinT = (const float*)(T + 188 * MiB); }
    else if (q == 1) { d.kind = K_GLU; }
    else if (q == 2) { d.kind = K_GEMM; gd_init(d.g, T, 2816, WB + OFF_FD, 2816, MTOK, 1024, 2816, EPI_RES, p.out, 1024); RES_PREV(layer * 3 + 2); }
    else { d.kind = K_LN; d.arg = layer * 3 + 2; }
}

__global__ void __launch_bounds__(512) mega(Params p_) {
    extern __shared__ __attribute__((aligned(16))) unsigned char smem[];
    LAS unsigned char* lds = (LAS unsigned char*)smem;
    cg::grid_group grid = cg::this_grid();
    const int ph_lo = p_.ph_lo, ph_hi = p_.ph_hi;
    volatile LAS unsigned* bst = (volatile LAS unsigned*)(lds + 131072);
    if (threadIdx.x == 0) { bst[0] = 0u; bst[1] = 0u; }
    __syncthreads();
    const XcdBarrier xb = xcd_barrier_post((unsigned*)(p_.ws + WS_MISC + MS_BAR), bst);
    for (int it_ = ph_lo; it_ < ph_hi; ++it_) {
#ifdef REP_PH
        const int ph = (it_ > REP_PH) ? it_ - 1 : it_;
#else
        const int ph = it_;
#endif
        int zero; asm volatile("s_mov_b32 %0, 0" : "=s"(zero));
        Ctx cx; cx.tid = threadIdx.x; cx.bid = blockIdx.x; asm volatile("" : "+v"(cx.tid)); asm volatile("" : "+s"(cx.bid));
        const Params& p = *(const Params*)((const char*)&p_ + zero);
        PhaseD d; make_desc(p, ph, d);
        if (it_ > ph_lo && !d.nosync) { if (ph_hi < 0) grid.sync(); else xcd_barrier(xb); }
        switch (d.kind) {
            case K_SETUP: setup_phase(cx, p, lds); break;
            case K_GEMM: gemm_phase(cx, lds, d.g); break;
            case K_SWA: swa_phase(cx, p, d.layer / 3, lds); break;
            case K_MLA: mla_phase(cx, p, lds); break;
            case K_LRUCONV: lruconv_phase(cx, p); break;
            case K_SCAN1: scan_phase<1>(cx, p); break;
            case K_SCAN2: scan_phase<2>(cx, p); break;
            case K_SCANMID: scanmid_phase(cx, p, lds); break;
            case K_GLU: glufix_phase(cx, p, d.layer); convert_set(cx, p, d.layer + 1, lds, 1); break;
            case K_MLAPREP: mlaprep_phase(cx, p); break;
            default: break;
        }
    }
}

extern "C" void kernel_launch(void* const* d_in, const int* in_sizes, int n_in, void* d_out, int out_size, void* d_ws, size_t ws_size, hipStream_t stream) {
    static int grid = 0;
    if (grid == 0) {
        if (n_in != 29 || ws_size < WS_NEED) { fprintf(stderr, "kernel_launch: unexpected n_in %d / ws_size %zu\n", n_in, ws_size); grid = -1; return; }
        int dev = 0, cus = 0, per_cu = 0;
        hipGetDevice(&dev);
        hipDeviceGetAttribute(&cus, hipDeviceAttributeMultiprocessorCount, dev);
        if (hipFuncSetAttribute((const void*)mega, hipFuncAttributeMaxDynamicSharedMemorySize, LDS_BYTES) != hipSuccess) { fprintf(stderr, "kernel_launch: hipFuncSetAttribute failed\n"); }
        if (hipOccupancyMaxActiveBlocksPerMultiprocessor(&per_cu, (const void*)mega, 512, LDS_BYTES) != hipSuccess || per_cu < 1) { fprintf(stderr, "kernel_launch: occupancy query gave %d\n", per_cu); per_cu = 1; }
        (void)hipGetLastError();
        grid = cus * per_cu;
        if (grid > 256) grid = 256;
    }
    if (grid < 0) return;
    (void)hipMemsetAsync((unsigned char*)d_ws + WS_MISC + MS_BAR, 0, 16384 + 32768, stream);
    Params p{};
    for (int i = 0; i < 29; ++i) p.in[i] = (const float*)d_in[i];
    p.out = (float*)d_out; p.ws = (unsigned char*)d_ws;
#if MULTI_LAUNCH
    for (int ph = 0; ph < NPHASES; ++ph) { p.ph_lo = ph; p.ph_hi = ph + 1; hipLaunchKernelGGL(mega, dim3(grid), dim3(512), LDS_BYTES, stream, p); }
#else
#ifdef REP_PH
    p.ph_lo = 0; p.ph_hi = NPHASES + 1;
#else
    p.ph_lo = 0; p.ph_hi = NPHASES;
#endif
    void* args[] = {&p};
    hipError_t e = hipLaunchCooperativeKernel((const void*)mega, dim3(grid), dim3(512), args, LDS_BYTES, stream);
    if (e != hipSuccess) fprintf(stderr, "cooperative launch failed: %s (grid %d)\n", hipGetErrorString(e), grid);
#endif
}
```
